# Optimizing an MI355X kernel written in HIP

```python
import math
import jax, jax.numpy as jnp
from jax import lax
import numpy as np

D_MODEL = 1024
BATCH = 4
SEQ = 8192
DEPTH = 1

GRID_W = 64
N_HEADS = 8
HEAD_DIM = 64
ATTN_W = N_HEADS * HEAD_DIM
NA_WIN_H = 8
NA_WIN_W = 16
SSM_W = 512
SSM_GROUP = 16
SSM_GROUPS = SSM_W // SSM_GROUP
SSM_STATE = 64
N_DIR = 2
DT_MIN = 1e-3
DT_MAX = 1e-1
LAMBDA_RE_MAX = -1e-4
N_BRANCH = 2
IN_COLS = 3 * ATTN_W + SSM_W + N_BRANCH * D_MODEL
D_FF = 2816
PLE_DIM = 256
RMS_EPS = 1e-6

kernel_name = "hybrid_natten_s5_macaron_block"


def rms_norm(x, g):
    xf = x.astype(jnp.float32)
    y = xf * lax.rsqrt(jnp.mean(xf * xf, axis=-1, keepdims=True) + RMS_EPS)
    return (y * g.astype(jnp.float32)).astype(x.dtype)


def swiglu(x, w_gate, w_up, w_down):
    return (jax.nn.silu(x @ w_gate) * (x @ w_up)) @ w_down


def neighbourhood_attention(q, k, v, rpb):
    bn, s, h, hd = q.shape
    rows = s // GRID_W
    wh = min(NA_WIN_H, rows)
    ww = NA_WIN_W
    scale = hd ** -0.5
    qg = q.reshape(bn, rows, GRID_W, h, hd)
    kg = k.reshape(bn, rows, GRID_W, h, hd)
    vg = v.reshape(bn, rows, GRID_W, h, hd)
    cols = jnp.arange(GRID_W)
    col_start = jnp.clip(cols - ww // 2, 0, GRID_W - ww)
    col_idx = col_start[:, None] + jnp.arange(ww)[None, :]
    dc_idx = col_idx - cols[:, None] + (NA_WIN_W - 1)

    def row_block(r):
        rs = jnp.clip(r - wh // 2, 0, rows - wh)
        kr = lax.dynamic_slice_in_dim(kg, rs, wh, axis=1)
        vr = lax.dynamic_slice_in_dim(vg, rs, wh, axis=1)
        kn = kr[:, :, col_idx]
        vn = vr[:, :, col_idx]
        qr = lax.dynamic_index_in_dim(qg, r, axis=1, keepdims=False)
        dr_idx = rs + jnp.arange(wh) - r + (NA_WIN_H - 1)
        bias = rpb[:, dr_idx[:, None, None], dc_idx[None]]
        bias = bias.transpose(0, 2, 1, 3)
        sc = jnp.einsum('bchd,brcwhd->bhcrw', qr, kn) * scale + bias[None]
        sc = sc.reshape(bn, h, GRID_W, wh * ww).astype(jnp.float32)
        pr = jax.nn.softmax(sc, axis=-1).astype(v.dtype).reshape(bn, h, GRID_W, wh, ww)
        return jnp.einsum('bhcrw,brcwhd->bchd', pr, vn)

    out = lax.map(row_block, jnp.arange(rows))
    return out.transpose(1, 0, 2, 3, 4).reshape(bn, s, h * hd)


def _ssm_combine(ei, ej):
    a_i, b_i = ei
    a_j, b_j = ej
    return a_j * a_i, a_j * b_i + b_j


def s5_scan(u, lam_re, lam_im, log_dt, b_re, b_im, c_re, c_im, reverse):
    f32 = jnp.float32
    s = u.shape[1]
    lam = lax.complex(jnp.minimum(lam_re.astype(f32), LAMBDA_RE_MAX), lam_im.astype(f32))
    dt = jnp.exp(log_dt.astype(f32))[:, None]
    lam_bar = jnp.exp(lam * dt)
    b_bar = ((lam_bar - 1.0) / lam)[..., None] * lax.complex(b_re.astype(f32), b_im.astype(f32))
    bu = lax.complex(jnp.einsum('bsgi,gpi->bsgp', u, b_bar.real),
                     jnp.einsum('bsgi,gpi->bsgp', u, b_bar.imag))
    a = jnp.broadcast_to(lam_bar, (1, s) + lam_bar.shape)
    _, states = lax.associative_scan(_ssm_combine, (a, bu), reverse=reverse, axis=1)
    return (jnp.einsum('bsgp,gop->bsgo', states.real, c_re.astype(f32))
            - jnp.einsum('bsgp,gop->bsgo', states.imag, c_im.astype(f32)))


def s5_branch(s_in, lam_re, lam_im, log_dt, b_re, b_im, c_re, c_im, d_skip, glu_w, glu_b):
    f32 = jnp.float32
    bn, s, _ = s_in.shape
    u = s_in.astype(f32).reshape(bn, s, SSM_GROUPS, SSM_GROUP)
    y = d_skip.astype(f32).reshape(SSM_GROUPS, SSM_GROUP) * u
    for direction in range(N_DIR):
        y = y + s5_scan(u, lam_re[direction], lam_im[direction], log_dt[direction],
                        b_re[direction], b_im[direction], c_re[direction], c_im[direction],
                        reverse=(direction == 1))
    y = jax.nn.gelu(y.reshape(bn, s, SSM_W))
    y = y * jax.nn.sigmoid(y @ glu_w.astype(f32) + glu_b.astype(f32))
    return y.astype(s_in.dtype)


def setup_inputs(seed: int = 0) -> dict:
    key = jax.random.key(seed)
    ks = iter(jax.random.split(key, 48))
    L = DEPTH
    f32 = jnp.float32

    def nrm(shape, fan_in):
        return jax.random.normal(next(ks), shape, f32) * fan_in ** -0.5

    def gain(shape):
        return 1.0 + 0.05 * jax.random.normal(next(ks), shape, f32)

    def small(shape, scale):
        return scale * jax.random.normal(next(ks), shape, f32)

    G, P, GC = SSM_GROUPS, SSM_STATE, SSM_GROUP
    return {
        "x": jax.random.normal(next(ks), (BATCH, SEQ, D_MODEL), f32),
        "p": jax.random.normal(next(ks), (DEPTH, BATCH, SEQ, PLE_DIM), f32),
        "ffn1_norm": gain((L, D_MODEL)),
        "ffn1_w_gate": nrm((L, D_MODEL, D_FF), D_MODEL),
        "ffn1_w_up": nrm((L, D_MODEL, D_FF), D_MODEL),
        "ffn1_w_down": nrm((L, D_FF, D_MODEL), D_FF),
        "mix_norm": gain((L, D_MODEL)),
        "w_in": nrm((L, D_MODEL, IN_COLS), D_MODEL),
        "na_rpb": small((L, N_HEADS, 2 * NA_WIN_H - 1, 2 * NA_WIN_W - 1), 0.02),
        "ssm_lam_re": -0.5 + small((L, N_DIR, G, P), 0.01),
        "ssm_lam_im": math.pi * jnp.arange(P, dtype=f32) + small((L, N_DIR, G, P), 0.01),
        "ssm_log_dt": jax.random.uniform(next(ks), (L, N_DIR, G), f32,
                                         minval=math.log(DT_MIN), maxval=math.log(DT_MAX)),
        "ssm_b_re": nrm((L, N_DIR, G, P, GC), 2 * GC),
        "ssm_b_im": nrm((L, N_DIR, G, P, GC), 2 * GC),
        "ssm_c_re": nrm((L, N_DIR, G, GC, P), 2 * P),
        "ssm_c_im": nrm((L, N_DIR, G, GC, P), 2 * P),
        "ssm_d": jax.random.normal(next(ks), (L, SSM_W), f32),
        "ssm_glu_w": nrm((L, SSM_W, SSM_W), SSM_W),
        "ssm_glu_b": small((L, SSM_W), 0.01),
        "w_attn_out": nrm((L, ATTN_W, D_MODEL), ATTN_W),
        "w_ssm_out": nrm((L, SSM_W, D_MODEL), SSM_W),
        "w_out": nrm((L, D_MODEL, D_MODEL), D_MODEL),
        "ffn2_norm": gain((L, D_MODEL)),
        "ffn2_w_gate": nrm((L, D_MODEL, D_FF), D_MODEL),
        "ffn2_w_up": nrm((L, D_MODEL, D_FF), D_MODEL),
        "ffn2_w_down": nrm((L, D_FF, D_MODEL), D_FF),
        "ple_norm": gain((L, D_MODEL)),
        "ple_w_gate": nrm((L, D_MODEL, D_MODEL), D_MODEL),
        "ple_w_proj": nrm((L, PLE_DIM, D_MODEL), PLE_DIM),
        "final_norm": gain((D_MODEL,)),
    }


def reference(x, p, ffn1_norm, ffn1_w_gate, ffn1_w_up, ffn1_w_down, mix_norm, w_in, na_rpb,
              ssm_lam_re, ssm_lam_im, ssm_log_dt, ssm_b_re, ssm_b_im, ssm_c_re, ssm_c_im,
              ssm_d, ssm_glu_w, ssm_glu_b, w_attn_out, w_ssm_out, w_out,
              ffn2_norm, ffn2_w_gate, ffn2_w_up, ffn2_w_down,
              ple_norm, ple_w_gate, ple_w_proj, final_norm):
    bn, s, _ = x.shape
    splits = [ATTN_W, 2 * ATTN_W, 3 * ATTN_W, 3 * ATTN_W + SSM_W]
    h = x
    for i in range(DEPTH):
        h = h + 0.5 * swiglu(rms_norm(h, ffn1_norm[i]), ffn1_w_gate[i], ffn1_w_up[i], ffn1_w_down[i])
        u = rms_norm(h, mix_norm[i])
        z = u @ w_in[i]
        q, k, v, s_in, gates = jnp.split(z, splits, axis=-1)
        y_attn = neighbourhood_attention(q.reshape(bn, s, N_HEADS, HEAD_DIM),
                                         k.reshape(bn, s, N_HEADS, HEAD_DIM),
                                         v.reshape(bn, s, N_HEADS, HEAD_DIM),
                                         na_rpb[i]) @ w_attn_out[i]
        y_ssm = s5_branch(s_in, ssm_lam_re[i], ssm_lam_im[i], ssm_log_dt[i],
                          ssm_b_re[i], ssm_b_im[i], ssm_c_re[i], ssm_c_im[i],
                          ssm_d[i], ssm_glu_w[i], ssm_glu_b[i]) @ w_ssm_out[i]
        g_attn, g_ssm = jnp.split(jax.nn.sigmoid(gates), N_BRANCH, axis=-1)
        h = h + (g_attn * y_attn + g_ssm * y_ssm) @ w_out[i]
        h = h + 0.5 * swiglu(rms_norm(h, ffn2_norm[i]), ffn2_w_gate[i], ffn2_w_up[i], ffn2_w_down[i])
        h = h + (p[i] @ ple_w_proj[i]) * jax.nn.sigmoid(rms_norm(h, ple_norm[i]) @ ple_w_gate[i])
    return rms_norm(h, final_norm)
```

```cpp
#include <hip/hip_runtime.h>
#include <cstdio>
#include <cstdint>

namespace nv {
constexpr int D = 1024, BATCH = 4, SEQ = 8192, GW = 64, ROWS = SEQ / GW, NH = 8, HD = 64, AW = 512, SW = 512, G = 32, GC = 16, P = 64, FF = 2816, PLE = 256, INC = 4096;
constexpr float EPS = 1e-6f;

__global__ void __launch_bounds__(256) sgemm(const float* __restrict__ A, int lda, const float* __restrict__ B, int ldb, float* __restrict__ C, int ldc, int K) {
    __shared__ float As[8][128 + 4];
    __shared__ float Bs[8][128 + 4];
    const int tid = threadIdx.x, tx = tid & 15, ty = tid >> 4;
    const int bm = blockIdx.y * 128, bn = blockIdx.x * 128;
    float acc[8][8];
#pragma unroll
    for (int i = 0; i < 8; ++i)
#pragma unroll
        for (int j = 0; j < 8; ++j) acc[i][j] = 0.f;
    const int ar = tid >> 1, ak = (tid & 1) * 4;
    const int bk = tid >> 5, bc = (tid & 31) * 4;
    for (int k0 = 0; k0 < K; k0 += 8) {
        const float4 a = *(const float4*)(A + (size_t)(bm + ar) * lda + k0 + ak);
        const float4 b = *(const float4*)(B + (size_t)(k0 + bk) * ldb + bn + bc);
        As[ak + 0][ar] = a.x; As[ak + 1][ar] = a.y; As[ak + 2][ar] = a.z; As[ak + 3][ar] = a.w;
        *(float4*)&Bs[bk][bc] = b;
        __syncthreads();
#pragma unroll
        for (int kk = 0; kk < 8; ++kk) {
            float av[8], bv[8];
            *(float4*)&av[0] = *(const float4*)&As[kk][ty * 8]; *(float4*)&av[4] = *(const float4*)&As[kk][ty * 8 + 4];
            *(float4*)&bv[0] = *(const float4*)&Bs[kk][tx * 8]; *(float4*)&bv[4] = *(const float4*)&Bs[kk][tx * 8 + 4];
#pragma unroll
            for (int i = 0; i < 8; ++i)
#pragma unroll
                for (int j = 0; j < 8; ++j) acc[i][j] = fmaf(av[i], bv[j], acc[i][j]);
        }
        __syncthreads();
    }
#pragma unroll
    for (int i = 0; i < 8; ++i) {
        float* cp = C + (size_t)(bm + ty * 8 + i) * ldc + bn + tx * 8;
        *(float4*)cp = make_float4(acc[i][0], acc[i][1], acc[i][2], acc[i][3]);
        *(float4*)(cp + 4) = make_float4(acc[i][4], acc[i][5], acc[i][6], acc[i][7]);
    }
}

__global__ void __launch_bounds__(256) rmsnorm_k(const float* __restrict__ x, const float* __restrict__ g, float* __restrict__ out, int rows) {
    const int row = blockIdx.x * 4 + (threadIdx.x >> 6), lane = threadIdx.x & 63;
    if (row >= rows) return;
    const float4* xr = (const float4*)(x + (size_t)row * D);
    float4 v[4]; float s = 0.f;
#pragma unroll
    for (int j = 0; j < 4; ++j) { v[j] = xr[lane + 64 * j]; s += v[j].x * v[j].x + v[j].y * v[j].y + v[j].z * v[j].z + v[j].w * v[j].w; }
#pragma unroll
    for (int o = 1; o < 64; o <<= 1) s += __shfl_xor(s, o);
    const float r = 1.0f / sqrtf(s * (1.0f / D) + EPS);
    float4* orow = (float4*)(out + (size_t)row * D);
#pragma unroll
    for (int j = 0; j < 4; ++j) { const float4 gg = ((const float4*)g)[lane + 64 * j]; orow[lane + 64 * j] = make_float4(v[j].x * r * gg.x, v[j].y * r * gg.y, v[j].z * r * gg.z, v[j].w * r * gg.w); }
}

__device__ __forceinline__ float sigmoidf_(float x) { return 1.0f / (1.0f + expf(-x)); }

__global__ void swiglu_k(const float* __restrict__ gt, const float* __restrict__ up, float* __restrict__ act, size_t n) {
    size_t i = (size_t)blockIdx.x * blockDim.x + threadIdx.x; if (i >= n) return;
    const float g = gt[i]; act[i] = g * sigmoidf_(g) * up[i];
}
__global__ void axpy_k(float* __restrict__ h, const float* __restrict__ y, float alpha, size_t n) {
    size_t i = (size_t)blockIdx.x * blockDim.x + threadIdx.x; if (i >= n) return;
    h[i] += alpha * y[i];
}
__global__ void __launch_bounds__(64) natten_k(const float* __restrict__ z, const float* __restrict__ rpb, float* __restrict__ out  ) {
    const int idx = blockIdx.x * 64 + threadIdx.x;
    const int tok = idx >> 3, h = idx & 7, r = tok / GW, c = tok % GW;
    int rs = r - 4; rs = rs < 0 ? 0 : (rs > ROWS - 8 ? ROWS - 8 : rs);
    int cs = c - 8; cs = cs < 0 ? 0 : (cs > GW - 16 ? GW - 16 : cs);
    const float* q = z + (size_t)tok * INC + h * HD;
    float mx = -1e30f;
    for (int j = 0; j < 8; ++j) for (int w = 0; w < 16; ++w) {
        const int kt = (rs + j) * GW + cs + w; const float* k = z + (size_t)kt * INC + AW + h * HD;
        float d = 0.f; for (int e = 0; e < HD; ++e) d = fmaf(q[e], k[e], d);
        const float s = d * 0.125f + rpb[(h * 15 + (rs + j - r + 7)) * 31 + (cs + w - c + 15)];
        mx = fmaxf(mx, s);
    }
    float o[HD];
#pragma unroll
    for (int e = 0; e < HD; ++e) o[e] = 0.f;
    float sum = 0.f;
    for (int j = 0; j < 8; ++j) for (int w = 0; w < 16; ++w) {
        const int kt = (rs + j) * GW + cs + w; const float* k = z + (size_t)kt * INC + AW + h * HD; const float* v = z + (size_t)kt * INC + 2 * AW + h * HD;
        float d = 0.f; for (int e = 0; e < HD; ++e) d = fmaf(q[e], k[e], d);
        const float s = d * 0.125f + rpb[(h * 15 + (rs + j - r + 7)) * 31 + (cs + w - c + 15)];
        const float p = expf(s - mx); sum += p;
#pragma unroll
        for (int e = 0; e < HD; ++e) o[e] = fmaf(p, v[e], o[e]);
    }
    const float inv = 1.0f / sum;
    float* op = out + (size_t)tok * AW + h * HD;
#pragma unroll
    for (int e = 0; e < HD; ++e) op[e] = o[e] * inv;
}

__global__ void __launch_bounds__(64) s5_k(const float* __restrict__ z, const float* __restrict__ lam_re, const float* __restrict__ lam_im, const float* __restrict__ log_dt,
                                           const float* __restrict__ b_re, const float* __restrict__ b_im, const float* __restrict__ c_re, const float* __restrict__ c_im,
                                           float* __restrict__ yf, float* __restrict__ yb) {
    __shared__ float xr[64][65], xi[64][65], cr[16][64], ci[16][64], us[64][16];
    const int g = blockIdx.x, dir = blockIdx.y, p = threadIdx.x;
    const int gp = (dir * G + g) * P + p;
    const double lr = fmin((double)lam_re[gp], -1e-4), li = (double)lam_im[gp], dt = exp((double)log_dt[dir * G + g]);
    const double er = exp(lr * dt), ar = er * cos(li * dt), ai = er * sin(li * dt);
    const double nr = ar - 1.0, ni = ai, den = lr * lr + li * li;
    const double fr = (nr * lr + ni * li) / den, fi = (ni * lr - nr * li) / den;
    float bbr[16], bbi[16];
#pragma unroll
    for (int i = 0; i < 16; ++i) { const double br = b_re[(size_t)gp * GC + i], bi = b_im[(size_t)gp * GC + i]; bbr[i] = (float)(fr * br - fi * bi); bbi[i] = (float)(fr * bi + fi * br); }
    for (int o = 0; o < 16; ++o) { cr[o][p] = c_re[((size_t)(dir * G + g) * GC + o) * P + p]; ci[o][p] = c_im[((size_t)(dir * G + g) * GC + o) * P + p]; }
    const float far = (float)ar, fai = (float)ai;
    float sr = 0.f, si = 0.f;
    float* y = dir ? yb : yf;
    for (int blk = 0; blk < SEQ / 64; ++blk) {
        __syncthreads();
        for (int e = p; e < 64 * 16; e += 64) { const int tt = e >> 4, i = e & 15; const int t = dir ? (SEQ - 1 - (blk * 64 + tt)) : (blk * 64 + tt); us[tt][i] = z[(size_t)t * INC + 3 * AW + g * GC + i]; }
        __syncthreads();
        for (int tt = 0; tt < 64; ++tt) {
            float br = 0.f, bi = 0.f;
#pragma unroll
            for (int i = 0; i < 16; ++i) { const float u = us[tt][i]; br = fmaf(bbr[i], u, br); bi = fmaf(bbi[i], u, bi); }
            const float nr2 = far * sr - fai * si + br, ni2 = far * si + fai * sr + bi; sr = nr2; si = ni2;
            xr[tt][p] = sr; xi[tt][p] = si;
        }
        __syncthreads();
        for (int e = p; e < 64 * 16; e += 64) { const int tt = e >> 4, o = e & 15; float a = 0.f;
            for (int q = 0; q < 64; ++q) a += xr[tt][q] * cr[o][q] - xi[tt][q] * ci[o][q];
            const int t = dir ? (SEQ - 1 - (blk * 64 + tt)) : (blk * 64 + tt); y[(size_t)t * SW + g * GC + o] = a; }
    }
}
__device__ __forceinline__ float gelu_tanh(float x) { const float c = 0.7978845608028654f; return 0.5f * x * (1.0f + tanhf(c * (x + 0.044715f * x * x * x))); }
__global__ void ssm_comb_k(const float* __restrict__ z, const float* __restrict__ dsk, const float* __restrict__ yf, const float* __restrict__ yb, float* __restrict__ y) {
    size_t i = (size_t)blockIdx.x * blockDim.x + threadIdx.x; const int t = (int)(i / SW), c = (int)(i % SW);
    const float u = z[(size_t)t * INC + 3 * AW + c];
    y[i] = gelu_tanh(dsk[c] * u + yf[i] + yb[i]);
}
__global__ void glu_k(const float* __restrict__ y, const float* __restrict__ t, const float* __restrict__ b, float* __restrict__ yg) {
    size_t i = (size_t)blockIdx.x * blockDim.x + threadIdx.x; const int c = (int)(i % SW);
    yg[i] = y[i] * sigmoidf_(t[i] + b[c]);
}
__global__ void merge_k(const float* __restrict__ z, const float* __restrict__ ya, const float* __restrict__ ys, float* __restrict__ m) {
    size_t i = (size_t)blockIdx.x * blockDim.x + threadIdx.x; const int t = (int)(i / D), c = (int)(i % D);
    m[i] = sigmoidf_(z[(size_t)t * INC + 2048 + c]) * ya[i] + sigmoidf_(z[(size_t)t * INC + 3072 + c]) * ys[i];
}
__global__ void ple_k(float* __restrict__ h, const float* __restrict__ proj, const float* __restrict__ gate, size_t n) {
    size_t i = (size_t)blockIdx.x * blockDim.x + threadIdx.x; if (i >= n) return;
    h[i] += proj[i] * sigmoidf_(gate[i]);
}
__global__ void copy_k(float* __restrict__ d, const float* __restrict__ s, size_t n) {
    size_t i = (size_t)blockIdx.x * blockDim.x + threadIdx.x; if (i >= n) return; d[i] = s[i];
}
}

extern "C" void kernel_launch(void* const* d_in, const int* in_sizes, int n_in, void* d_out, int out_size, void* d_ws, size_t ws_size, hipStream_t stream) {
    using namespace nv;
    const float* x = (const float*)d_in[0]; const float* pin = (const float*)d_in[1];
    const float* ffn1_norm = (const float*)d_in[2]; const float* ffn1_wg = (const float*)d_in[3]; const float* ffn1_wu = (const float*)d_in[4]; const float* ffn1_wd = (const float*)d_in[5];
    const float* mix_norm = (const float*)d_in[6]; const float* w_in = (const float*)d_in[7]; const float* rpb = (const float*)d_in[8];
    const float* lam_re = (const float*)d_in[9]; const float* lam_im = (const float*)d_in[10]; const float* log_dt = (const float*)d_in[11];
    const float* b_re = (const float*)d_in[12]; const float* b_im = (const float*)d_in[13]; const float* c_re = (const float*)d_in[14]; const float* c_im = (const float*)d_in[15];
    const float* ssm_d = (const float*)d_in[16]; const float* glu_w = (const float*)d_in[17]; const float* glu_b = (const float*)d_in[18];
    const float* w_attn_out = (const float*)d_in[19]; const float* w_ssm_out = (const float*)d_in[20]; const float* w_out = (const float*)d_in[21];
    const float* ffn2_norm = (const float*)d_in[22]; const float* ffn2_wg = (const float*)d_in[23]; const float* ffn2_wu = (const float*)d_in[24]; const float* ffn2_wd = (const float*)d_in[25];
    const float* ple_norm = (const float*)d_in[26]; const float* ple_wg = (const float*)d_in[27]; const float* ple_wp = (const float*)d_in[28]; const float* final_norm = (const float*)d_in[29];
    float* out = (float*)d_out;
    float* ws = (float*)d_ws;
    const size_t MB = SEQ;
    float* hb  = ws;
    float* xn  = hb + MB * D;
    float* big = xn + MB * D;
    float* t1  = big + MB * INC;
    float* t2  = t1 + MB * FF;
    float* t3  = t2 + MB * D;
    float* t4  = t3 + MB * D;
    auto gemm = [&](const float* A, int lda, const float* B, int ldb, float* C, int ldc, int M, int N, int K) {
        hipLaunchKernelGGL(sgemm, dim3(N / 128, M / 128), dim3(256), 0, stream, A, lda, B, ldb, C, ldc, K);
    };
    auto ew = [&](size_t n) { return dim3((unsigned)((n + 255) / 256)); };
    for (int b = 0; b < BATCH; ++b) {
        const float* xb = x + (size_t)b * MB * D; const float* pb = pin + (size_t)b * MB * PLE; float* ob = out + (size_t)b * MB * D;
        hipLaunchKernelGGL(copy_k, ew(MB * D), dim3(256), 0, stream, hb, xb, MB * D);
        hipLaunchKernelGGL(rmsnorm_k, dim3(MB / 4), dim3(256), 0, stream, hb, ffn1_norm, xn, (int)MB);
        float* gt = big; float* up = big + MB * FF;
        gemm(xn, D, ffn1_wg, FF, gt, FF, MB, FF, D);
        gemm(xn, D, ffn1_wu, FF, up, FF, MB, FF, D);
        hipLaunchKernelGGL(swiglu_k, ew(MB * FF), dim3(256), 0, stream, gt, up, gt, MB * FF);
        gemm(gt, FF, ffn1_wd, D, t4, D, MB, D, FF);
        hipLaunchKernelGGL(axpy_k, ew(MB * D), dim3(256), 0, stream, hb, t4, 0.5f, MB * D);
        hipLaunchKernelGGL(rmsnorm_k, dim3(MB / 4), dim3(256), 0, stream, hb, mix_norm, xn, (int)MB);
        float* z = big;
        gemm(xn, D, w_in, INC, z, INC, MB, INC, D);
        float* ao = t1;
        float* yf = t1 + MB * AW;
        float* yb = yf + MB * SW;
        float* yy = yb + MB * SW;
        float* tt = yy + MB * SW;
        hipLaunchKernelGGL(natten_k, dim3(SEQ * NH / 64), dim3(64), 0, stream, z, rpb, ao);
        hipLaunchKernelGGL(s5_k, dim3(G, 2), dim3(64), 0, stream, z, lam_re, lam_im, log_dt, b_re, b_im, c_re, c_im, yf, yb);
        hipLaunchKernelGGL(ssm_comb_k, ew(MB * SW), dim3(256), 0, stream, z, ssm_d, yf, yb, yy);
        gemm(yy, SW, glu_w, SW, tt, SW, MB, SW, SW);
        hipLaunchKernelGGL(glu_k, ew(MB * SW), dim3(256), 0, stream, yy, tt, glu_b, yf);
        gemm(ao, AW, w_attn_out, D, t2, D, MB, D, AW);
        gemm(yf, SW, w_ssm_out, D, t3, D, MB, D, SW);
        hipLaunchKernelGGL(merge_k, ew(MB * D), dim3(256), 0, stream, z, t2, t3, t4);
        gemm(t4, D, w_out, D, t2, D, MB, D, D);
        hipLaunchKernelGGL(axpy_k, ew(MB * D), dim3(256), 0, stream, hb, t2, 1.0f, MB * D);
        hipLaunchKernelGGL(rmsnorm_k, dim3(MB / 4), dim3(256), 0, stream, hb, ffn2_norm, xn, (int)MB);
        gemm(xn, D, ffn2_wg, FF, gt, FF, MB, FF, D);
        gemm(xn, D, ffn2_wu, FF, up, FF, MB, FF, D);
        hipLaunchKernelGGL(swiglu_k, ew(MB * FF), dim3(256), 0, stream, gt, up, gt, MB * FF);
        gemm(gt, FF, ffn2_wd, D, t4, D, MB, D, FF);
        hipLaunchKernelGGL(axpy_k, ew(MB * D), dim3(256), 0, stream, hb, t4, 0.5f, MB * D);
        hipLaunchKernelGGL(rmsnorm_k, dim3(MB / 4), dim3(256), 0, stream, hb, ple_norm, xn, (int)MB);
        gemm(xn, D, ple_wg, D, t2, D, MB, D, D);
        gemm(pb, PLE, ple_wp, D, t3, D, MB, D, PLE);
        hipLaunchKernelGGL(ple_k, ew(MB * D), dim3(256), 0, stream, hb, t3, t2, MB * D);
        hipLaunchKernelGGL(rmsnorm_k, dim3(MB / 4), dim3(256), 0, stream, hb, final_norm, ob, (int)MB);
    }
}
```

```cpp
#include <hip/hip_runtime.h>
#include <cstdio>
#include <cstdint>

#ifndef MK_MODE
#define MK_MODE 1
#endif
#ifndef MK_SCAFFOLD
#define MK_SCAFFOLD 0
#endif
#ifndef PH_MASK
#define PH_MASK 0x3fff
#endif

#define LAS __attribute__((address_space(3)))
#define GAS __attribute__((address_space(1)))
typedef unsigned short bf16_t;
typedef short bf16x8 __attribute__((ext_vector_type(8)));
typedef float f32x4 __attribute__((ext_vector_type(4)));
typedef float f32x2 __attribute__((ext_vector_type(2)));
typedef unsigned u32x4 __attribute__((ext_vector_type(4)));
typedef unsigned u32x2 __attribute__((ext_vector_type(2)));

constexpr int BATCH = 4, SEQ = 8192, D = 1024, M = BATCH * SEQ, FF = 2816, NIN = 4096, AW = 512, SW = 512, PLE = 256;
constexpr int NHEAD = 8, HD = 64, GW = 64, ROWS = SEQ / GW;
constexpr int NG = 32, GC = 16, NP = 64, TC = 32, NC = SEQ / TC;
constexpr float RMS_EPS = 1e-6f;

constexpr size_t MiB = 1u << 20;
constexpr size_t WS_CTL = 0, CTL_ZERO_BYTES = 2 * MiB;
constexpr size_t WS_SS = 1 * MiB;
constexpr size_t WS_WGU1 = 2 * MiB, WS_WD1 = 13 * MiB, WS_WIN = 19 * MiB, WS_WGLU = 27 * MiB, WS_WOS = 28 * MiB, WS_WOUT = 30 * MiB;
constexpr size_t WS_WGU2 = 32 * MiB, WS_WD2 = 43 * MiB, WS_WPG = 49 * MiB, WS_WPP = 51 * MiB;
constexpr size_t WS_BT1 = 52 * MiB, WS_BT2 = 76 * MiB, WS_AT = 84 * MiB;
constexpr size_t WS_HB = 86 * MiB;
constexpr size_t WS_AO = WS_HB, WS_YG = WS_HB + 32 * MiB;
constexpr size_t WS_BIG = 150 * MiB;
constexpr size_t WS_ACT = WS_BIG;
constexpr size_t WS_PROJ = 342 * MiB;
constexpr size_t WS_PB = 326 * MiB;
constexpr size_t WS_Q = 150 * MiB, WS_K = 182 * MiB, WS_V = 214 * MiB, WS_U = 246 * MiB, WS_GA = 278 * MiB, WS_GS = 342 * MiB;
constexpr size_t WS_YI = 406 * MiB, WS_E = 438 * MiB, WS_XC = 470 * MiB;
constexpr size_t WS_Y = WS_V, WS_MRG = WS_Q;
constexpr size_t WS_YF = 406 * MiB;
constexpr size_t WS_END = 512 * MiB;
constexpr int CW_TMO = 0, CW_BAR = 4096;

constexpr int RING_BYTES = 131072, LDS_BYTES = 147456, MISC_OFF = LDS_BYTES - 256;

typedef __bf16 bf16x2_t __attribute__((ext_vector_type(2)));
__device__ __forceinline__ unsigned cvt_pk_bf16(float lo, float hi) { const f32x2 v = {lo, hi}; const bf16x2_t b = __builtin_convertvector(v, bf16x2_t); return __builtin_bit_cast(unsigned, b); }
__device__ __forceinline__ float bf_lo(unsigned w) { return __uint_as_float(w << 16); }
__device__ __forceinline__ float bf_hi(unsigned w) { return __uint_as_float(w & 0xffff0000u); }
__device__ __forceinline__ float bf2f(bf16_t b) { return __uint_as_float((unsigned)b << 16); }
__device__ __forceinline__ bf16_t f2bf(float f) { unsigned u = __float_as_uint(f); return (bf16_t)((u + 0x7fffu + ((u >> 16) & 1u)) >> 16); }
__device__ __forceinline__ float fsigmoid(float x) { return __builtin_amdgcn_rcpf(1.0f + __builtin_amdgcn_exp2f(-1.4426950408889634f * x)); }
__device__ __forceinline__ float gelu_tanh_f(float x) { return x * fsigmoid(1.5957691216057308f * (x + 0.044715f * x * x * x)); }
typedef unsigned long long u64;
constexpr float SS_SCALE = 1048576.0f;
__device__ __forceinline__ float rinv_of(u64 ss) { return 1.0f / sqrtf((float)ss * (1.0f / (SS_SCALE * D)) + RMS_EPS); }
__device__ __forceinline__ float rinv_f(float ss) { return 1.0f / sqrtf(ss * (1.0f / D) + RMS_EPS); }
__device__ __forceinline__ u64 ss_fix(float s) { return (u64)(s * SS_SCALE + 0.5f); }
__device__ __forceinline__ u32x4 pack8(f32x4 a, f32x4 b) { u32x4 w; w.x = cvt_pk_bf16(a[0], a[1]); w.y = cvt_pk_bf16(a[2], a[3]); w.z = cvt_pk_bf16(b[0], b[1]); w.w = cvt_pk_bf16(b[2], b[3]); return w; }
__device__ __forceinline__ void unpack8(u32x4 w, f32x4& a, f32x4& b) { a = (f32x4){bf_lo(w.x), bf_hi(w.x), bf_lo(w.y), bf_hi(w.y)}; b = (f32x4){bf_lo(w.z), bf_hi(w.z), bf_lo(w.w), bf_hi(w.w)}; }
__device__ __forceinline__ float sq8(f32x4 a, f32x4 b) { return (a[0] * a[0] + a[1] * a[1]) + (a[2] * a[2] + a[3] * a[3]) + (b[0] * b[0] + b[1] * b[1]) + (b[2] * b[2] + b[3] * b[3]); }

namespace pg8 {
constexpr int BM = 256, BK = 64, HALF = 128, HTB = HALF * BK * 2, STAGE_BYTES = 8 * HTB, NXCD = 8, WGM = 8;
__host__ __device__ __forceinline__ int lds_byte(int r, int c) { const int st = (r >> 4) * 2 + (c >> 5), rr = r & 15, cc = c & 31, ob = rr * 64 + cc * 2; return st * 1024 + (ob ^ (((ob >> 9) & 1) << 5)); }
__host__ __device__ __forceinline__ void stage_rc(int b, int& R, int& C) { const int st = b / 1024, sb = b % 1024, swz = sb ^ (((sb >> 9) & 1) << 5); R = (st >> 1) * 16 + swz / 64; C = (st & 1) * 32 + (swz % 64) / 2; }
__host__ __device__ __forceinline__ int perm32(int rho) { const int n = rho >> 4, i = rho & 15; return 8 * (i >> 2) + 4 * n + (i & 3); }

struct Unit { int pm, pn, grp; size_t aoff, boff; };
struct Gemm { const char* A; const char* Bt; int K; unsigned lda, ldb; unsigned kstepA; int amap; };

__device__ __forceinline__ bool static_tile(int L, int nM, int nN, int& pm, int& pn) {
    const int nwg = nM * nN; if (L >= nwg) return false;
    int wgid = L; { const int q = nwg / NXCD, r = nwg % NXCD, xcd = wgid % NXCD, off = wgid / NXCD; wgid = (xcd < r ? xcd * (q + 1) : r * (q + 1) + (xcd - r) * q) + off; }
    const int nig = WGM * nN, gid = wgid / nig, fm = gid * WGM, gsz = (nM - fm) < WGM ? (nM - fm) : WGM;
    pm = fm + ((wgid % nig) % gsz); pn = (wgid % nig) / gsz; return true;
}
struct PlainOrder {
    int nM, nN, G, c; unsigned lda, ldb;
    __device__ __forceinline__ bool next(int i, Unit& u) const {
        if (!static_tile(i * G + c, nM, nN, u.pm, u.pn)) return false;
        u.grp = 0; u.aoff = (size_t)u.pm * 256 * lda * 2; u.boff = (size_t)u.pn * 256 * ldb * 2; return true; }
};
struct MixOrder {
    int G, c; size_t a0, b0, a1, b1;
    __device__ __forceinline__ bool next(int i, Unit& u) const {
        const int L = i * G + c; constexpr int NGLU = (M / 256) * (SW / 256);
        if (L < NGLU) { if (!static_tile(L, M / 256, SW / 256, u.pm, u.pn)) return false; u.grp = 0; u.aoff = a0 + (size_t)u.pm * 256 * 512 * 2; u.boff = b0 + (size_t)u.pn * 256 * 512 * 2; return true; }
        if (!static_tile(L - NGLU, M / 256, D / 256, u.pm, u.pn)) return false; u.grp = 1; u.aoff = a1 + (size_t)u.pm * 256 * 512 * 2; u.boff = b1 + (size_t)u.pn * 256 * 512 * 2; return true; }
};
struct SsmOrder {
    int npn, G, c; size_t a_g, a_b, b_g, b_pn;
    __device__ __forceinline__ bool next(int i, Unit& u) const {
        const int L = i * G + c; if (L >= NG * BATCH * npn) return false;
        const int g = L / (BATCH * npn), rem = L % (BATCH * npn); u.grp = g; u.pn = rem / BATCH; u.pm = rem % BATCH;
        u.aoff = (size_t)g * a_g + (size_t)u.pm * a_b; u.boff = (size_t)g * b_g + (size_t)u.pn * b_pn; return true; }
};

template <class Epi, class Sched, bool ALIGN_EPI>
__device__ __forceinline__ void gemm_phase(LAS unsigned char* lds, const Gemm g, const Sched& S, const Epi& E) {
    const int tid = threadIdx.x, wid = __builtin_amdgcn_readfirstlane(tid >> 6), lane = tid & 63, wr = wid >> 2, wc = wid & 3, fr = lane & 15, fq = lane >> 4;
    int Kop = g.K; asm volatile("" : "+s"(Kop));
    const int nt = Kop / BK;
    unsigned voffA[2], voffB[2];
#pragma unroll
    for (int i = 0; i < 2; ++i) { int R, C; stage_rc(tid * 16 + i * 8192, R, C); const int Rb = (R & ~31) + perm32(R & 31);
        const int Ca = g.amap ? ((C >> 4) * 512 + (C & 15)) : C;
        voffA[i] = (unsigned)(R * (int)g.lda + Ca) * 2u; voffB[i] = (unsigned)(Rb * (int)g.ldb + C) * 2u; }
    const size_t kstepA = (size_t)g.kstepA, kstepB = (size_t)(BK * 2);
    const size_t hstepA = (size_t)HALF * g.lda * 2, hstepB = (size_t)HALF * g.ldb * 2;
    const unsigned ldsw = (unsigned)wid * 1024u;
    const int aoff = lds_byte(wr * 64 + fr, fq * 8), boff = lds_byte(wc * 32 + fr, fq * 8);
#define PG8_SA(b, h) (((b) * 2 + (h)) * HTB)
#define PG8_SB(b, h) ((4 + (b) * 2 + (h)) * HTB)
#define PG8_STAGE(bufoff, gbase, voff) do { _Pragma("unroll") for (int _i = 0; _i < 2; ++_i) \
        __builtin_amdgcn_global_load_lds((const unsigned*)((const char*)(gbase) + (voff)[_i]), (LAS unsigned*)(lds + (bufoff) + ldsw + _i * 8192), 16, 0, 0); } while (0)
#define PG8_LDA(dst, b, h) do { _Pragma("unroll") for (int m = 0; m < 4; ++m) _Pragma("unroll") for (int k = 0; k < 2; ++k) dst[m][k] = *(const LAS bf16x8*)(lds + PG8_SA(b, h) + aoff + m * 2048 + k * 1024); } while (0)
#define PG8_LDB(dst, b, h) do { _Pragma("unroll") for (int n = 0; n < 2; ++n) _Pragma("unroll") for (int k = 0; k < 2; ++k) dst[n][k] = *(const LAS bf16x8*)(lds + PG8_SB(b, h) + boff + n * 2048 + k * 1024); } while (0)
#define PG8_MMA(ai, bj, At, Bt) do { __builtin_amdgcn_s_setprio(1); _Pragma("unroll") for (int m = 0; m < 4; ++m) _Pragma("unroll") for (int n = 0; n < 2; ++n) _Pragma("unroll") for (int k = 0; k < 2; ++k) \
        acc[ai][bj][m][n] = __builtin_amdgcn_mfma_f32_16x16x32_bf16(Bt[n][k], At[m][k], acc[ai][bj][m][n], 0, 0, 0); __builtin_amdgcn_s_setprio(0); } while (0)
#define PG8_WAIT_V(n) asm volatile("s_waitcnt vmcnt(" #n ")" ::: "memory")
#define PG8_WAIT_L(n) asm volatile("s_waitcnt lgkmcnt(" #n ")" ::: "memory")
#define PG8_BAR __builtin_amdgcn_s_barrier()
#define PG8_SCHED __builtin_amdgcn_sched_barrier(0)
    Unit cur, nxt; int ui = 0;
    if (!S.next(0, cur)) return;
    f32x4 acc[2][2][4][2];
#pragma unroll
    for (int a = 0; a < 2; ++a)
#pragma unroll
        for (int b = 0; b < 2; ++b)
#pragma unroll
            for (int m = 0; m < 4; ++m)
#pragma unroll
                for (int n = 0; n < 2; ++n) acc[a][b][m][n] = (f32x4){0.f, 0.f, 0.f, 0.f};
    bf16x8 At[4][2], B0[2][2], B1[2][2];
    const char* cA = g.A + cur.aoff; const char* cB = g.Bt + cur.boff;
    PG8_STAGE(PG8_SB(0, 0), cB, voffB); PG8_STAGE(PG8_SB(0, 1), cB + hstepB, voffB); PG8_STAGE(PG8_SA(0, 0), cA, voffA); PG8_STAGE(PG8_SA(0, 1), cA + hstepA, voffA);
    if (wr == 1) PG8_BAR;
    PG8_WAIT_V(2); PG8_BAR;
    PG8_STAGE(PG8_SB(1, 0), cB + kstepB, voffB); PG8_STAGE(PG8_SA(1, 0), cA + kstepA, voffA); PG8_STAGE(PG8_SB(1, 1), cB + hstepB + kstepB, voffB);
    PG8_WAIT_V(6); PG8_BAR;
    for (;;) {
        const bool has_next = S.next(ui + 1, nxt);
        const char* nA = has_next ? g.A + nxt.aoff : cA; const char* nB = has_next ? g.Bt + nxt.boff : cB;
        for (int t = 0; t < nt; t += 2) {
            const bool last = (t == nt - 2);
            const char* a1 = cA + (size_t)(t + 1) * kstepA;
            const char* a2 = last ? nA : cA + (size_t)(t + 2) * kstepA; const char* b2 = last ? nB : cB + (size_t)(t + 2) * kstepB;
            const char* a3 = a2 + kstepA; const char* b3 = b2 + kstepB;
            PG8_LDB(B0, 0, 0); PG8_LDB(B1, 0, 1); PG8_SCHED; PG8_LDA(At, 0, 0); PG8_STAGE(PG8_SA(1, 1), a1 + hstepA, voffA);
            PG8_WAIT_V(8); PG8_WAIT_L(0); PG8_BAR; PG8_MMA(0, 0, At, B0); PG8_MMA(0, 1, At, B1); PG8_BAR; PG8_SCHED;
            PG8_LDA(At, 0, 1); PG8_STAGE(PG8_SB(0, 0), b2, voffB); PG8_STAGE(PG8_SB(0, 1), b2 + hstepB, voffB); PG8_STAGE(PG8_SA(0, 0), a2, voffA);
            PG8_WAIT_V(8); PG8_WAIT_L(0); PG8_BAR; PG8_MMA(1, 0, At, B0); PG8_MMA(1, 1, At, B1); PG8_BAR; PG8_SCHED;
            PG8_LDB(B0, 1, 0); PG8_LDB(B1, 1, 1); PG8_SCHED; PG8_LDA(At, 1, 0); PG8_STAGE(PG8_SA(0, 1), a2 + hstepA, voffA);
            PG8_WAIT_V(8); PG8_WAIT_L(0); PG8_BAR; PG8_MMA(0, 0, At, B0); PG8_MMA(0, 1, At, B1); PG8_BAR; PG8_SCHED;
            PG8_LDA(At, 1, 1); PG8_STAGE(PG8_SB(1, 0), b3, voffB); PG8_STAGE(PG8_SB(1, 1), b3 + hstepB, voffB); PG8_STAGE(PG8_SA(1, 0), a3, voffA);
            PG8_WAIT_V(8); PG8_WAIT_L(0); PG8_BAR; PG8_MMA(1, 0, At, B0); PG8_MMA(1, 1, At, B1); PG8_BAR; PG8_SCHED;
        }
        if constexpr (ALIGN_EPI) { if (wr == 0) PG8_BAR; }
        E(acc, cur, wr, wc, fr, fq);
        if (!has_next) break;
#pragma unroll
        for (int a = 0; a < 2; ++a)
#pragma unroll
            for (int b = 0; b < 2; ++b)
#pragma unroll
                for (int m = 0; m < 4; ++m)
#pragma unroll
                    for (int n = 0; n < 2; ++n) acc[a][b][m][n] = (f32x4){0.f, 0.f, 0.f, 0.f};
        cur = nxt; cA = nA; cB = nB; ++ui;
        if constexpr (ALIGN_EPI) { if (wr == 1) PG8_BAR; }
    }
    PG8_WAIT_V(0);
    if constexpr (!ALIGN_EPI) { if (wr == 0) PG8_BAR; }
    PG8_BAR;
#undef PG8_SA
#undef PG8_SB
#undef PG8_STAGE
#undef PG8_LDA
#undef PG8_LDB
#undef PG8_MMA
#undef PG8_WAIT_V
#undef PG8_WAIT_L
#undef PG8_BAR
#undef PG8_SCHED
}
}

typedef f32x4 AccT[2][2][4][2];
using pg8::Unit;
struct EpiSwiglu { bf16_t* act; const u64* ss;
    __device__ __forceinline__ void operator()(const AccT& acc, const Unit& u, int wr, int wc, int fr, int fq) const {
        const int row0 = u.pm * 256 + wr * 64 + fr, col0 = u.pn * 128 + wc * 32 + 8 * fq;
#pragma unroll
        for (int ai = 0; ai < 2; ++ai)
#pragma unroll
            for (int m = 0; m < 4; ++m) { const int row = row0 + ai * 128 + m * 16; const float rr = rinv_of(ss[row]);
                f32x4 o[2];
#pragma unroll
                for (int n = 0; n < 2; ++n)
#pragma unroll
                    for (int e = 0; e < 4; ++e) { const float gv = acc[ai][0][m][n][e] * rr, uv = acc[ai][1][m][n][e] * rr; o[n][e] = gv * fsigmoid(gv) * uv; }
                *(u32x4*)(act + (size_t)row * FF + col0) = pack8(o[0], o[1]); }
    }
};
struct EpiResid { const float* base; float* out; bf16_t* hb; u64* ssn; float alpha;
    __device__ __forceinline__ void operator()(const AccT& acc, const Unit& u, int wr, int wc, int fr, int fq) const {
        const int row0 = u.pm * 256 + wr * 64 + fr, col0 = u.pn * 256 + wc * 32 + 8 * fq;
#pragma unroll
        for (int ai = 0; ai < 2; ++ai)
#pragma unroll
            for (int m = 0; m < 4; ++m) { const int row = row0 + ai * 128 + m * 16; float sq = 0.f;
#pragma unroll
                for (int bj = 0; bj < 2; ++bj) { const size_t off = (size_t)row * D + col0 + bj * 128;
                    const f32x4 b0 = *(const f32x4*)(base + off), b1 = *(const f32x4*)(base + off + 4);
                    const f32x4 h0 = b0 + alpha * acc[ai][bj][m][0], h1 = b1 + alpha * acc[ai][bj][m][1];
                    *(f32x4*)(out + off) = h0; *(f32x4*)(out + off + 4) = h1; *(u32x4*)(hb + off) = pack8(h0, h1); sq += sq8(h0, h1); }
                sq += __shfl_xor(sq, 16); sq += __shfl_xor(sq, 32);
                if (fq == 0) atomicAdd(ssn + row, ss_fix(sq));
                asm volatile("" ::: "memory"); }
    }
};
struct EpiWin { bf16_t* qkvu; bf16_t* gg; const u64* ss;
    __device__ __forceinline__ void operator()(const AccT& acc, const Unit& u, int wr, int wc, int fr, int fq) const {
        const int row0 = u.pm * 256 + wr * 64 + fr; const int pn = u.pn;
        if (pn < 8) { const int t = pn >> 1; bf16_t* dst = qkvu + (size_t)t * M * 512; const int col0 = (pn & 1) * 256 + wc * 32 + 8 * fq; const float sc = (t == 0) ? 0.125f : 1.0f;
#pragma unroll
            for (int ai = 0; ai < 2; ++ai)
#pragma unroll
                for (int m = 0; m < 4; ++m) { const int row = row0 + ai * 128 + m * 16; const float rr = rinv_of(ss[row]) * sc;
#pragma unroll
                    for (int bj = 0; bj < 2; ++bj) *(u32x4*)(dst + (size_t)row * 512 + col0 + bj * 128) = pack8(acc[ai][bj][m][0] * rr, acc[ai][bj][m][1] * rr); }
        } else { const int w = (pn - 8) >> 2; bf16_t* dst = gg + (size_t)w * M * D; const int col0 = ((pn - 8) & 3) * 256 + wc * 32 + 8 * fq;
#pragma unroll
            for (int ai = 0; ai < 2; ++ai)
#pragma unroll
                for (int m = 0; m < 4; ++m) { const int row = row0 + ai * 128 + m * 16; const float rr = rinv_of(ss[row]);
#pragma unroll
                    for (int bj = 0; bj < 2; ++bj) { f32x4 o[2];
#pragma unroll
                        for (int n = 0; n < 2; ++n)
#pragma unroll
                            for (int e = 0; e < 4; ++e) o[n][e] = fsigmoid(acc[ai][bj][m][n][e] * rr);
                        *(u32x4*)(dst + (size_t)row * D + col0 + bj * 128) = pack8(o[0], o[1]); } }
        }
    }
};
struct EpiSsm1 { bf16_t* yi; float* E;
    __device__ __forceinline__ void operator()(const AccT& acc, const Unit& u, int wr, int wc, int fr, int fq) const {
        const int g = u.grp, b = u.pm;
#pragma unroll
        for (int ai = 0; ai < 2; ++ai)
#pragma unroll
            for (int m = 0; m < 4; ++m) { const int c = ai * 128 + wr * 64 + m * 16 + fr;
#pragma unroll
                for (int bj = 0; bj < 2; ++bj) { const int n = bj * 128 + wc * 32 + 8 * fq;
                    if (u.pn < 2) { const int nn = u.pn * 256 + n, tau = nn >> 4, o = nn & 15;
                        *(u32x4*)(yi + ((size_t)b * SEQ + c * TC + tau) * SW + g * GC + o) = pack8(acc[ai][bj][m][0], acc[ai][bj][m][1]); }
                    else { float* e = E + ((size_t)(g * BATCH + b) * NC + c) * 256 + n; *(f32x4*)e = acc[ai][bj][m][0]; *(f32x4*)(e + 4) = acc[ai][bj][m][1]; } } }
    }
};
struct EpiSsm2 { const bf16_t* yi; bf16_t* y;
    __device__ __forceinline__ void operator()(const AccT& acc, const Unit& u, int wr, int wc, int fr, int fq) const {
        const int g = u.grp, b = u.pm;
#pragma unroll
        for (int ai = 0; ai < 2; ++ai)
#pragma unroll
            for (int m = 0; m < 4; ++m) { const int c = ai * 128 + wr * 64 + m * 16 + fr;
#pragma unroll
                for (int bj = 0; bj < 2; ++bj) { const int nn = u.pn * 256 + bj * 128 + wc * 32 + 8 * fq, tau = nn >> 4, o = nn & 15;
                    const size_t off = ((size_t)b * SEQ + c * TC + tau) * SW + g * GC + o;
                    f32x4 i0, i1; unpack8(*(const u32x4*)(yi + off), i0, i1); i0 += acc[ai][bj][m][0]; i1 += acc[ai][bj][m][1];
#pragma unroll
                    for (int e = 0; e < 4; ++e) { i0[e] = gelu_tanh_f(i0[e]); i1[e] = gelu_tanh_f(i1[e]); }
                    *(u32x4*)(y + off) = pack8(i0, i1); }
                asm volatile("" ::: "memory"); }
    }
};
struct EpiMix { const bf16_t* y; bf16_t* yg; const float* bias; const bf16_t* ga; bf16_t* mrg;
    __device__ __forceinline__ void operator()(const AccT& acc, const Unit& u, int wr, int wc, int fr, int fq) const {
        const int row0 = u.pm * 256 + wr * 64 + fr, col0 = u.pn * 256 + wc * 32 + 8 * fq;
        if (u.grp == 0) {
#pragma unroll
            for (int bj = 0; bj < 2; ++bj) { const f32x4 bv0 = *(const f32x4*)(bias + col0 + bj * 128), bv1 = *(const f32x4*)(bias + col0 + bj * 128 + 4);
#pragma unroll
                for (int ai = 0; ai < 2; ++ai)
#pragma unroll
                    for (int m = 0; m < 4; ++m) { const size_t off = (size_t)(row0 + ai * 128 + m * 16) * SW + col0 + bj * 128;
                        f32x4 y0, y1; unpack8(*(const u32x4*)(y + off), y0, y1); const f32x4 t0 = acc[ai][bj][m][0] + bv0, t1 = acc[ai][bj][m][1] + bv1;
#pragma unroll
                        for (int e = 0; e < 4; ++e) { y0[e] *= fsigmoid(t0[e]); y1[e] *= fsigmoid(t1[e]); }
                        *(u32x4*)(yg + off) = pack8(y0, y1);
                        asm volatile("" ::: "memory"); } }
        } else {
#pragma unroll
            for (int ai = 0; ai < 2; ++ai)
#pragma unroll
                for (int m = 0; m < 4; ++m)
#pragma unroll
                    for (int bj = 0; bj < 2; ++bj) { const size_t off = (size_t)(row0 + ai * 128 + m * 16) * D + col0 + bj * 128;
                        f32x4 g0, g1; unpack8(*(const u32x4*)(ga + off), g0, g1);
                        *(u32x4*)(mrg + off) = pack8(g0 * acc[ai][bj][m][0], g1 * acc[ai][bj][m][1]);
                        asm volatile("" ::: "memory"); }
        }
    }
};
struct EpiSsmProj { const bf16_t* gs; bf16_t* mrg;
    __device__ __forceinline__ void operator()(const AccT& acc, const Unit& u, int wr, int wc, int fr, int fq) const {
        const int row0 = u.pm * 256 + wr * 64 + fr, col0 = u.pn * 256 + wc * 32 + 8 * fq;
#pragma unroll
        for (int ai = 0; ai < 2; ++ai)
#pragma unroll
            for (int m = 0; m < 4; ++m)
#pragma unroll
                for (int bj = 0; bj < 2; ++bj) { const size_t off = (size_t)(row0 + ai * 128 + m * 16) * D + col0 + bj * 128;
                    f32x4 g0, g1, p0, p1; unpack8(*(const u32x4*)(gs + off), g0, g1); unpack8(*(const u32x4*)(mrg + off), p0, p1);
                    *(u32x4*)(mrg + off) = pack8(p0 + g0 * acc[ai][bj][m][0], p1 + g1 * acc[ai][bj][m][1]);
                    asm volatile("" ::: "memory"); }
    }
};
struct EpiStoreF32 { float* out;
    __device__ __forceinline__ void operator()(const AccT& acc, const Unit& u, int wr, int wc, int fr, int fq) const {
        const int row0 = u.pm * 256 + wr * 64 + fr, col0 = u.pn * 256 + wc * 32 + 8 * fq;
#pragma unroll
        for (int ai = 0; ai < 2; ++ai)
#pragma unroll
            for (int m = 0; m < 4; ++m)
#pragma unroll
                for (int bj = 0; bj < 2; ++bj) { float* o = out + (size_t)(row0 + ai * 128 + m * 16) * D + col0 + bj * 128; *(f32x4*)o = acc[ai][bj][m][0]; *(f32x4*)(o + 4) = acc[ai][bj][m][1]; }
    }
};
struct EpiPleGate { float* h; const float* proj; const u64* ss;
    __device__ __forceinline__ void operator()(const AccT& acc, const Unit& u, int wr, int wc, int fr, int fq) const {
        const int row0 = u.pm * 256 + wr * 64 + fr, col0 = u.pn * 256 + wc * 32 + 8 * fq;
#pragma unroll
        for (int ai = 0; ai < 2; ++ai)
#pragma unroll
            for (int m = 0; m < 4; ++m) { const int row = row0 + ai * 128 + m * 16; const float rr = rinv_of(ss[row]);
#pragma unroll
                for (int bj = 0; bj < 2; ++bj) { const size_t off = (size_t)row * D + col0 + bj * 128;
#pragma unroll
                    for (int n = 0; n < 2; ++n) { const f32x4 hv = *(const f32x4*)(h + off + 4 * n), pv = *(const f32x4*)(proj + off + 4 * n); f32x4 o;
#pragma unroll
                        for (int e = 0; e < 4; ++e) o[e] = hv[e] + pv[e] * fsigmoid(acc[ai][bj][m][n][e] * rr);
                        *(f32x4*)(h + off + 4 * n) = o; }
                    asm volatile("" ::: "memory"); } }
    }
};

#define XB_TMO      128
#define XB_XCNT(j)  (256  + 64 * (j))
#define XB_XSUB(j)  (1280 + 64 * (j))
#define XB_XGEN(j)  (2304 + 64 * (j))
#define XB_TOP      3328
#define XB_TOPGEN   3392
#define XCD_BAR_WORDS 3456
#define XB_SPIN_CAP (1u << 18)
__device__ __forceinline__ unsigned xb_ld(unsigned* p)              { return __hip_atomic_load(p, __ATOMIC_RELAXED, __HIP_MEMORY_SCOPE_AGENT); }
__device__ __forceinline__ unsigned xb_add(unsigned* p, unsigned v) { return __hip_atomic_fetch_add(p, v, __ATOMIC_RELAXED, __HIP_MEMORY_SCOPE_AGENT); }
__device__ __forceinline__ unsigned xb_xcc_id() { return (unsigned)__builtin_amdgcn_s_getreg((3 << 11) | 20) & 0xFu; }
#define XB_SPIN(cond, bar) do { unsigned _sp = 0; while (cond) { __builtin_amdgcn_s_sleep(1); \
    if ((++_sp & 255u) == 0u) { if (xb_ld(&(bar)[XB_TMO])) break; if (_sp > XB_SPIN_CAP) { atomicAdd(&(bar)[XB_TMO], 1u); break; } } } } while (0)
struct XcdBarrier { unsigned* bar; unsigned x; volatile LAS unsigned* st; };
__device__ __forceinline__ XcdBarrier xcd_barrier_post(unsigned* bar, volatile LAS unsigned* st) {
    XcdBarrier b; b.bar = bar; b.x = xb_xcc_id(); b.st = st;
    if (threadIdx.x == 0) (void)xb_add(&bar[XB_XCNT(b.x)], 1u);
    return b;
}
__device__ __forceinline__ void xcd_barrier_complete(unsigned* bar, unsigned x, unsigned& nloc, unsigned& nx) {
    const unsigned G = gridDim.x * gridDim.y * gridDim.z;
    unsigned sum, cnt, mine, sp = 0u;
    for (;;) {
        sum = 0u; cnt = 0u; mine = 0u;
#pragma unroll
        for (unsigned j = 0; j < 16; ++j) { const unsigned c = xb_ld(&bar[XB_XCNT(j)]); sum += c; cnt += (c > 0u) ? 1u : 0u; mine = (j == x) ? c : mine; }
        if (sum == G) break;
        __builtin_amdgcn_s_sleep(1);
        if ((++sp & 255u) == 0u) { if (xb_ld(&bar[XB_TMO])) break; if (sp > XB_SPIN_CAP) { atomicAdd(&bar[XB_TMO], 1u); break; } }
    }
    nloc = mine > 0u ? mine : 1u; nx = cnt > 0u ? cnt : 1u;
}
__device__ __forceinline__ void xcd_barrier(const XcdBarrier& b) {
    asm volatile("s_waitcnt vmcnt(0)" ::: "memory");
    __syncthreads();
    if (threadIdx.x == 0) {
        unsigned* bar = b.bar;
        __builtin_amdgcn_s_waitcnt(0);
        unsigned nloc = b.st[0], nx = b.st[1];
        if (nloc == 0u) { xcd_barrier_complete(bar, b.x, nloc, nx); b.st[0] = nloc; b.st[1] = nx; }
        const unsigned old = xb_add(&bar[XB_XSUB(b.x)], 1u);
        const unsigned gen = old / nloc;
        if (old + 1u == (gen + 1u) * nloc) {
            __builtin_amdgcn_fence(__ATOMIC_RELEASE, "agent");
            asm volatile("s_waitcnt vmcnt(0)" ::: "memory");
            const unsigned og = xb_add(&bar[XB_TOP], 1u);
            const unsigned tg = og / nx;
            if (og + 1u == (tg + 1u) * nx) xb_add(&bar[XB_TOPGEN], 1u);
            else XB_SPIN(xb_ld(&bar[XB_TOPGEN]) == tg, bar);
            __builtin_amdgcn_fence(__ATOMIC_ACQUIRE, "agent");
            xb_add(&bar[XB_XGEN(b.x)], 1u);
            asm volatile("s_waitcnt vmcnt(0)" ::: "memory");
        } else {
            XB_SPIN(xb_ld(&bar[XB_XGEN(b.x)]) == gen, bar);
            __builtin_amdgcn_fence(__ATOMIC_ACQUIRE, "agent");
            asm volatile("s_waitcnt vmcnt(0)" ::: "memory");
        }
    }
    __syncthreads();
}

#define LDS_WAIT() asm volatile("s_waitcnt lgkmcnt(0)" ::: "memory")
__device__ __forceinline__ unsigned pk2(float lo, float hi) { return (unsigned)f2bf(lo) | ((unsigned)f2bf(hi) << 16); }
__device__ __forceinline__ void p0_transpose_item(const float* W, int K, int N, bf16_t* WT, int grp, int gstride, int goff, const float* gain, LAS float* scr, int item, int lane) {
    const int nblk = N / 32, kb = item / nblk, nb = item % nblk, k0 = 64 * kb, n0 = 32 * nb;
#pragma unroll 8
    for (int i = 0; i < 32; ++i) { const int kk = 2 * i + (lane >> 5); float w = W[(size_t)(k0 + kk) * N + n0 + (lane & 31)]; if (gain) w *= gain[k0 + kk]; scr[kk * 33 + (lane & 31)] = w; }
    LDS_WAIT(); asm volatile("" ::: "memory");
    const int c = lane & 7;
#pragma unroll
    for (int j = 0; j < 4; ++j) { const int n = (lane >> 3) + 8 * j; const LAS float* s = scr + (8 * c) * 33 + n; const int nn = n0 + n, dr = (nn / grp) * gstride + goff + nn % grp;
        u32x4 o; o.x = pk2(s[0 * 33], s[1 * 33]); o.y = pk2(s[2 * 33], s[3 * 33]); o.z = pk2(s[4 * 33], s[5 * 33]); o.w = pk2(s[6 * 33], s[7 * 33]);
        *(u32x4*)(WT + (size_t)dr * K + k0 + 8 * c) = o; }
    LDS_WAIT(); asm volatile("" ::: "memory");
}
__device__ __forceinline__ float wave_sum(float v) {
#pragma unroll
    for (int o = 1; o < 64; o <<= 1) v += __shfl_xor(v, o);
    return v;
}
__device__ __forceinline__ void p0_ssm_group(LAS unsigned char* lds, int g, const float* lam_re, const float* lam_im, const float* log_dt, const float* b_re, const float* b_im,
                                              const float* c_re, const float* c_im, const float* dsk, bf16_t* Bt1, bf16_t* Bt2, f32x2* aT) {
    LAS f32x2* bb = (LAS f32x2*)lds; LAS f32x2* ap = (LAS f32x2*)(lds + 16384); LAS f32x2* cc = (LAS f32x2*)(lds + 50176); LAS float* kt = (LAS float*)(lds + 66560);
    const int tid = threadIdx.x;
    if (tid < 128) {
        const int dir = tid >> 6, p = tid & 63, gp = (dir * NG + g) * NP + p;
        const double lr = fmin((double)lam_re[gp], -1e-4), li = (double)lam_im[gp], dt = exp((double)log_dt[dir * NG + g]);
        const double er = exp(lr * dt), ar = er * cos(li * dt), ai = er * sin(li * dt);
        const double nr = ar - 1.0, ni = ai, den = lr * lr + li * li;
        const double fr = (nr * lr + ni * li) / den, fi = (ni * lr - nr * li) / den;
        for (int i = 0; i < GC; ++i) { const double br = b_re[(size_t)gp * GC + i], bi = b_im[(size_t)gp * GC + i]; bb[(dir * 64 + p) * 16 + i] = (f32x2){(float)(fr * br - fi * bi), (float)(fr * bi + fi * br)}; }
        double pr = 1.0, pi = 0.0;
        for (int k = 0; k <= TC; ++k) { ap[(dir * 64 + p) * 33 + k] = (f32x2){(float)pr, (float)pi}; const double t = pr * ar - pi * ai; pi = pr * ai + pi * ar; pr = t; }
        aT[gp] = ap[(dir * 64 + p) * 33 + TC];
    }
    for (int e = tid; e < 2 * 16 * 64; e += 512) { const int dir = e >> 10, o = (e >> 6) & 15, p = e & 63; const size_t ci = ((size_t)(dir * NG + g) * GC + o) * NP + p; cc[e] = (f32x2){c_re[ci], c_im[ci]}; }
    __syncthreads();
    for (int e = tid; e < 2 * 32 * 16 * 4; e += 512) { const int i4 = (e & 3) * 4, o = (e >> 2) & 15, k = (e >> 6) & 31, dir = e >> 11;
        float s0 = 0.f, s1 = 0.f, s2 = 0.f, s3 = 0.f;
        for (int p = 0; p < 64; ++p) { const f32x2 c = cc[(dir * 16 + o) * 64 + p], a = ap[(dir * 64 + p) * 33 + k]; const float wr_ = c.x * a.x - c.y * a.y, wi_ = c.x * a.y + c.y * a.x;
            const LAS f32x2* b = bb + (dir * 64 + p) * 16 + i4;
            s0 += wr_ * b[0].x - wi_ * b[0].y; s1 += wr_ * b[1].x - wi_ * b[1].y; s2 += wr_ * b[2].x - wi_ * b[2].y; s3 += wr_ * b[3].x - wi_ * b[3].y; }
        LAS float* d = kt + ((dir * 32 + k) * 16 + o) * 16 + i4; d[0] = s0; d[1] = s1; d[2] = s2; d[3] = s3; }
    __syncthreads();
    bf16_t* B1 = Bt1 + (size_t)g * 768 * 512;
    for (int e = tid; e < 512 * 64; e += 512) { const int n = e >> 6, k8 = (e & 63) * 8, tau = n >> 4, o = n & 15, sg = k8 >> 4, i0 = k8 & 15;
        float v[8];
        if (tau != sg) { const int dir = tau > sg ? 0 : 1, lag = tau > sg ? tau - sg : sg - tau; const LAS float* s = kt + ((dir * 32 + lag) * 16 + o) * 16 + i0;
#pragma unroll
            for (int j = 0; j < 8; ++j) v[j] = s[j]; }
        else { const LAS float* s0 = kt + ((0 * 32 + 0) * 16 + o) * 16 + i0; const LAS float* s1 = kt + ((1 * 32 + 0) * 16 + o) * 16 + i0; const float dd = dsk[g * GC + o];
#pragma unroll
            for (int j = 0; j < 8; ++j) v[j] = s0[j] + s1[j] + ((i0 + j) == o ? dd : 0.f); }
        u32x4 w; w.x = pk2(v[0], v[1]); w.y = pk2(v[2], v[3]); w.z = pk2(v[4], v[5]); w.w = pk2(v[6], v[7]);
        *(u32x4*)(B1 + (size_t)n * 512 + k8) = w; }
    for (int e = tid; e < 256 * 64; e += 512) { const int r = e >> 6, k8 = (e & 63) * 8, q = r >> 6, p = r & 63, dir = q >> 1, sg = k8 >> 4, i0 = k8 & 15;
        const f32x2 a = ap[(dir * 64 + p) * 33 + (dir == 0 ? (TC - 1 - sg) : sg)]; float v[8];
#pragma unroll
        for (int j = 0; j < 8; ++j) { const f32x2 b = bb[(dir * 64 + p) * 16 + i0 + j]; v[j] = (q & 1) ? (a.x * b.y + a.y * b.x) : (a.x * b.x - a.y * b.y); }
        u32x4 w; w.x = pk2(v[0], v[1]); w.y = pk2(v[2], v[3]); w.z = pk2(v[4], v[5]); w.w = pk2(v[6], v[7]);
        *(u32x4*)(B1 + (size_t)(512 + r) * 512 + k8) = w; }
    bf16_t* B2 = Bt2 + (size_t)g * 512 * 256;
    for (int e = tid; e < 512 * 32; e += 512) { const int n = e >> 5, k8 = (e & 31) * 8, tau = n >> 4, o = n & 15, q = k8 >> 6, p0 = k8 & 63, dir = q >> 1; float v[8];
#pragma unroll
        for (int j = 0; j < 8; ++j) { const int p = p0 + j; const f32x2 c = cc[(dir * 16 + o) * 64 + p], a = ap[(dir * 64 + p) * 33 + (dir == 0 ? tau + 1 : TC - tau)];
            v[j] = (q & 1) ? -(c.x * a.y + c.y * a.x) : (c.x * a.x - c.y * a.y); }
        u32x4 w; w.x = pk2(v[0], v[1]); w.y = pk2(v[2], v[3]); w.z = pk2(v[4], v[5]); w.w = pk2(v[6], v[7]);
        *(u32x4*)(B2 + (size_t)n * 256 + k8) = w; }
    __syncthreads();
}


typedef short s16x4 __attribute__((ext_vector_type(4)));
__device__ __forceinline__ s16x4 tr_read(const LAS unsigned char* p) { return __builtin_bit_cast(s16x4, __builtin_amdgcn_ds_read_tr16_b64_v4i16((LAS s16x4*)p)); }
constexpr int ATT_V_BYTES = 9 * 64 * 128, ATT_RPB_OFF = ATT_V_BYTES;
__device__ __forceinline__ void attn_phase(LAS unsigned char* lds, const bf16_t* __restrict__ Q, const bf16_t* __restrict__ Kg, const bf16_t* __restrict__ Vg, const float* __restrict__ rpb, bf16_t* __restrict__ AO, int G, int bx) {
    const int tid = threadIdx.x, lane = tid & 63, w = __builtin_amdgcn_readfirstlane(tid >> 6), g4 = lane >> 4, l15 = lane & 15;
    LAS float* rp = (LAS float*)(lds + ATT_RPB_OFF);
    constexpr int NUNITS = BATCH * NHEAD * (ROWS / 2);
    for (int un = bx; un < NUNITS; un += G) {
        const int per = (NUNITS + G - 1) / G; const int u2 = (un % G) * per + un / G; if (u2 >= NUNITS) continue;
        const int bh = u2 / (ROWS / 2), rpair = u2 % (ROWS / 2), b = bh >> 3, h = bh & 7, r0 = 2 * rpair;
        int rsu = r0 - 4; rsu = rsu < 0 ? 0 : (rsu > ROWS - 8 ? ROWS - 8 : rsu);
        __syncthreads();
        { const int t = tid >> 3, c = tid & 7;
#pragma unroll
          for (int j = 0; j < 9; ++j) { const int row = rsu + j; if (row < ROWS) { const u32x4 v = *(const u32x4*)(Vg + ((size_t)b * SEQ + row * GW + t) * AW + h * HD + c * 8);
              *(LAS u32x4*)(lds + (j * 64 + t) * 128 + ((c ^ (t & 7)) << 4)) = v; } }
          if (tid < 465) rp[tid] = rpb[h * 465 + tid]; }
        const int r = r0 + (w >> 2), c0 = (w & 3) * 16;
        int rs = r - 4; rs = rs < 0 ? 0 : (rs > ROWS - 8 ? ROWS - 8 : rs);
        int wst = c0 - 8; wst = wst < 0 ? 0 : (wst > 32 ? 32 : wst);
        const size_t tq = (size_t)b * SEQ + r * GW + c0 + l15;
        bf16x8 qf[2];
#pragma unroll
        for (int kk = 0; kk < 2; ++kk) qf[kk] = *(const bf16x8*)(Q + tq * AW + h * HD + 8 * g4 + 32 * kk);
        f32x4 sacc[8][2];
        const bf16_t* kbase = Kg + ((size_t)b * SEQ + rs * GW + wst + l15) * AW + h * HD + 8 * g4;
#pragma unroll
        for (int kr = 0; kr < 8; ++kr)
#pragma unroll
            for (int nb = 0; nb < 2; ++nb) { f32x4 a = {0.f, 0.f, 0.f, 0.f};
#pragma unroll
                for (int kk = 0; kk < 2; ++kk) { const bf16x8 kf = *(const bf16x8*)(kbase + (size_t)(kr * GW + nb * 16) * AW + 32 * kk); a = __builtin_amdgcn_mfma_f32_16x16x32_bf16(kf, qf[kk], a, 0, 0, 0); }
                sacc[kr][nb] = a; }
        __syncthreads();
        const int c = c0 + l15; int cs = c - 8; cs = cs < 0 ? 0 : (cs > GW - 16 ? GW - 16 : cs);
        float mx = -1e30f;
#pragma unroll
        for (int kr = 0; kr < 8; ++kr) { const LAS float* brow = rp + (rs + kr - r + 7) * 31;
#pragma unroll
            for (int nb = 0; nb < 2; ++nb)
#pragma unroll
                for (int e = 0; e < 4; ++e) { const int kc = wst + 16 * nb + 4 * g4 + e; const bool ok = (kc >= cs) && (kc < cs + 16); const int dc = ok ? (kc - c + 15) : 0;
                    const float sv = ok ? sacc[kr][nb][e] + brow[dc] : -1e30f; sacc[kr][nb][e] = sv; mx = fmaxf(mx, sv); } }
        mx = fmaxf(mx, __shfl_xor(mx, 16)); mx = fmaxf(mx, __shfl_xor(mx, 32));
        float sum = 0.f; bf16x8 pb[8];
#pragma unroll
        for (int kr = 0; kr < 8; ++kr) { float pv[8];
#pragma unroll
            for (int nb = 0; nb < 2; ++nb)
#pragma unroll
                for (int e = 0; e < 4; ++e) { const float p = __builtin_amdgcn_exp2f((sacc[kr][nb][e] - mx) * 1.4426950408889634f); pv[nb * 4 + e] = p; sum += p; }
            u32x4 wv; wv.x = cvt_pk_bf16(pv[0], pv[1]); wv.y = cvt_pk_bf16(pv[2], pv[3]); wv.z = cvt_pk_bf16(pv[4], pv[5]); wv.w = cvt_pk_bf16(pv[6], pv[7]);
            pb[kr] = __builtin_bit_cast(bf16x8, wv); }
        sum += __shfl_xor(sum, 16); sum += __shfl_xor(sum, 32);
        f32x4 oacc[4];
#pragma unroll
        for (int d = 0; d < 4; ++d) oacc[d] = (f32x4){0.f, 0.f, 0.f, 0.f};
        const int q4 = (lane >> 2) & 3, p4 = lane & 3;
#pragma unroll
        for (int kr = 0; kr < 8; ++kr) { const int slot = rs + kr - rsu;
            const int t0 = wst + 4 * g4 + q4, t1 = t0 + 16;
            const LAS unsigned char* row0 = lds + (slot * 64 + t0) * 128 + (p4 & 1) * 8; const LAS unsigned char* row1 = lds + (slot * 64 + t1) * 128 + (p4 & 1) * 8;
#pragma unroll
            for (int d = 0; d < 4; ++d) { const int ch = 2 * d + (p4 >> 1);
                const s16x4 v0 = tr_read(row0 + ((ch ^ (t0 & 7)) << 4)), v1 = tr_read(row1 + ((ch ^ (t1 & 7)) << 4));
                bf16x8 vf; vf[0] = v0[0]; vf[1] = v0[1]; vf[2] = v0[2]; vf[3] = v0[3]; vf[4] = v1[0]; vf[5] = v1[1]; vf[6] = v1[2]; vf[7] = v1[3];
                oacc[d] = __builtin_amdgcn_mfma_f32_16x16x32_bf16(vf, pb[kr], oacc[d], 0, 0, 0); } }
        const float inv = 1.0f / sum;
#pragma unroll
        for (int d = 0; d < 4; ++d) { const f32x4 o = oacc[d] * inv; *(u32x2*)(AO + tq * AW + h * HD + 16 * d + 4 * g4) = (u32x2){cvt_pk_bf16(o[0], o[1]), cvt_pk_bf16(o[2], o[3])}; }
    }
    __syncthreads();
}

struct Args { const float* in[30]; float* out; unsigned char* ws; int ph_lo, ph_hi; };
constexpr int N_PHASES = 14;

__global__ void __launch_bounds__(512, 2) mk_fwd(Args args) {
    extern __shared__ __attribute__((aligned(16))) unsigned char lds_raw[];
    LAS unsigned char* lds = (LAS unsigned char*)lds_raw;
    volatile LAS unsigned* MISC = (volatile LAS unsigned*)(lds + MISC_OFF);
    const int tid = threadIdx.x, lane = tid & 63, wave = __builtin_amdgcn_readfirstlane(tid >> 6);
    const int G = gridDim.x, bx = blockIdx.x;
    unsigned char* ws = args.ws;
    unsigned* ctl = (unsigned*)(ws + WS_CTL);
    u64* ss0 = (u64*)(ws + WS_SS); u64* ss1 = ss0 + M; u64* ss2 = ss1 + M; u64* ss3 = ss2 + M;
    float* hout = args.out;
    bf16_t* HB = (bf16_t*)(ws + WS_HB);
    const int lo = args.ph_lo, hi = args.ph_hi;
#define IN(k) (((PH_MASK >> (k)) & 1) && lo <= (k) && (k) < hi)
#define BOTH(k) (IN(k) && IN((k) + 1))
    for (int u = tid; u < 64; u += 512) MISC[u] = 0u;
    __syncthreads();
    XcdBarrier bar; bar.bar = ctl + CW_BAR; bar.x = 0; bar.st = nullptr;
    if (hi - lo > 1) bar = xcd_barrier_post(ctl + CW_BAR, MISC + 8);
#define GRID_BAR() xcd_barrier(bar)
    const int gw = bx * 8 + wave, NGW = G * 8;

    if (IN(0)) {
        const float* x = args.in[0];
        const int nssm = (G > 64) ? NG : 0;
        if (G > 64) { if (bx < NG) p0_ssm_group(lds, bx, args.in[9], args.in[10], args.in[11], args.in[12], args.in[13], args.in[14], args.in[15], args.in[16], (bf16_t*)(ws + WS_BT1), (bf16_t*)(ws + WS_BT2), (f32x2*)(ws + WS_AT)); }
        else { for (int g = bx; g < NG; g += G) p0_ssm_group(lds, g, args.in[9], args.in[10], args.in[11], args.in[12], args.in[13], args.in[14], args.in[15], args.in[16], (bf16_t*)(ws + WS_BT1), (bf16_t*)(ws + WS_BT2), (f32x2*)(ws + WS_AT)); }
        if (bx >= nssm) {
            LAS float* scr = (LAS float*)(lds + wave * 16384);
            const int w0 = (bx - nssm) * 8 + wave, NW = (G - nssm) * 8;
            constexpr int I_GU = (D / 64) * (FF / 32), I_DN = (FF / 64) * (D / 32), I_IN = (D / 64) * (NIN / 32), I_GLU = (SW / 64) * (SW / 32), I_O = (AW / 64) * (D / 32), I_DD = (D / 64) * (D / 32), I_PP = (PLE / 64) * (D / 32);
            constexpr int NITEMS = 4 * I_GU + 2 * I_DN + I_IN + I_GLU + 2 * I_O + 2 * I_DD + I_PP;
            for (int it = w0; it < NITEMS; it += NW) {
                int r = it;
                if (r < I_GU) { p0_transpose_item(args.in[3], D, FF, (bf16_t*)(ws + WS_WGU1), 128, 256, 0, args.in[2], scr, r, lane); continue; } r -= I_GU;
                if (r < I_GU) { p0_transpose_item(args.in[4], D, FF, (bf16_t*)(ws + WS_WGU1), 128, 256, 128, args.in[2], scr, r, lane); continue; } r -= I_GU;
                if (r < I_DN) { p0_transpose_item(args.in[5], FF, D, (bf16_t*)(ws + WS_WD1), D, 0, 0, nullptr, scr, r, lane); continue; } r -= I_DN;
                if (r < I_IN) { p0_transpose_item(args.in[7], D, NIN, (bf16_t*)(ws + WS_WIN), NIN, 0, 0, args.in[6], scr, r, lane); continue; } r -= I_IN;
                if (r < I_GLU) { p0_transpose_item(args.in[17], SW, SW, (bf16_t*)(ws + WS_WGLU), SW, 0, 0, nullptr, scr, r, lane); continue; } r -= I_GLU;
                if (r < I_O) { p0_transpose_item(args.in[19], AW, D, (bf16_t*)(ws + WS_WOS), D, 0, 0, nullptr, scr, r, lane); continue; } r -= I_O;
                if (r < I_O) { p0_transpose_item(args.in[20], SW, D, (bf16_t*)(ws + WS_WOS), D, 0, D, nullptr, scr, r, lane); continue; } r -= I_O;
                if (r < I_DD) { p0_transpose_item(args.in[21], D, D, (bf16_t*)(ws + WS_WOUT), D, 0, 0, nullptr, scr, r, lane); continue; } r -= I_DD;
                if (r < I_GU) { p0_transpose_item(args.in[23], D, FF, (bf16_t*)(ws + WS_WGU2), 128, 256, 0, args.in[22], scr, r, lane); continue; } r -= I_GU;
                if (r < I_GU) { p0_transpose_item(args.in[24], D, FF, (bf16_t*)(ws + WS_WGU2), 128, 256, 128, args.in[22], scr, r, lane); continue; } r -= I_GU;
                if (r < I_DN) { p0_transpose_item(args.in[25], FF, D, (bf16_t*)(ws + WS_WD2), D, 0, 0, nullptr, scr, r, lane); continue; } r -= I_DN;
                if (r < I_DD) { p0_transpose_item(args.in[27], D, D, (bf16_t*)(ws + WS_WPG), D, 0, 0, args.in[26], scr, r, lane); continue; } r -= I_DD;
                p0_transpose_item(args.in[28], PLE, D, (bf16_t*)(ws + WS_WPP), D, 0, 0, nullptr, scr, r, lane);
            }
            for (int m = w0; m < M; m += NW) {
                const f32x4* xr = (const f32x4*)(x + (size_t)m * D) + lane; f32x4 v[4]; float s = 0.f;
#pragma unroll
                for (int j = 0; j < 4; ++j) { v[j] = xr[64 * j]; s += (v[j][0] * v[j][0] + v[j][1] * v[j][1]) + (v[j][2] * v[j][2] + v[j][3] * v[j][3]); }
                s = wave_sum(s); if (lane == 0) ss0[m] = ss_fix(s);
                u32x2* o8 = (u32x2*)(HB + (size_t)m * D) + lane;
#pragma unroll
                for (int j = 0; j < 4; ++j) o8[64 * j] = (u32x2){cvt_pk_bf16(v[j][0], v[j][1]), cvt_pk_bf16(v[j][2], v[j][3])};
            }
        }
        if (BOTH(0)) GRID_BAR();
    }
    if (IN(1)) {
        pg8::Gemm g{(const char*)HB, (const char*)(ws + WS_WGU1), D, D, D, 128, 0}; pg8::PlainOrder S{M / 256, 2 * FF / 256, G, bx, D, D};
        EpiSwiglu E{(bf16_t*)(ws + WS_ACT), ss0};
        pg8::gemm_phase<EpiSwiglu, pg8::PlainOrder, true>(lds, g, S, E);
        if (BOTH(1)) GRID_BAR();
    }
    if (IN(2)) {
        pg8::Gemm g{(const char*)(ws + WS_ACT), (const char*)(ws + WS_WD1), FF, FF, FF, 128, 0}; pg8::PlainOrder S{M / 256, D / 256, G, bx, FF, FF};
        EpiResid E{args.in[0], hout, HB, ss1, 0.5f};
        pg8::gemm_phase<EpiResid, pg8::PlainOrder, true>(lds, g, S, E);
        if (BOTH(2)) GRID_BAR();
    }
    if (IN(3)) {
        pg8::Gemm g{(const char*)HB, (const char*)(ws + WS_WIN), D, D, D, 128, 0}; pg8::PlainOrder S{M / 256, NIN / 256, G, bx, D, D};
        EpiWin E{(bf16_t*)(ws + WS_Q), (bf16_t*)(ws + WS_GA), ss1};
        pg8::gemm_phase<EpiWin, pg8::PlainOrder, true>(lds, g, S, E);
        if (BOTH(3)) GRID_BAR();
    }
    if (IN(4)) {
        attn_phase(lds, (const bf16_t*)(ws + WS_Q), (const bf16_t*)(ws + WS_K), (const bf16_t*)(ws + WS_V), args.in[8], (bf16_t*)(ws + WS_AO), G, bx);
        pg8::Gemm g{(const char*)(ws + WS_U), (const char*)(ws + WS_BT1), 512, (unsigned)(TC * SW), 512, (unsigned)(4 * SW * 2), 1};
        pg8::SsmOrder S{3, G, bx, (size_t)GC * 2, (size_t)SEQ * SW * 2, (size_t)768 * 512 * 2, (size_t)256 * 512 * 2};
        EpiSsm1 E{(bf16_t*)(ws + WS_YI), (float*)(ws + WS_E)};
        pg8::gemm_phase<EpiSsm1, pg8::SsmOrder, true>(lds, g, S, E);
        if (BOTH(4)) GRID_BAR();
    }
    if (IN(5)) {
        const float* E = (const float*)(ws + WS_E); bf16_t* XC = (bf16_t*)(ws + WS_XC); const f32x2* aTt = (const f32x2*)(ws + WS_AT);
        LAS f32x2* endst = (LAS f32x2*)lds;
        for (int un = bx; un < NG * BATCH; un += G) {
            const int g = un >> 2, b = un & 3, rec = tid & 127, dir = rec >> 6, p = rec & 63, seg = tid >> 7;
            const f32x2 a = aTt[(dir * NG + g) * NP + p];
            const size_t rb = ((size_t)(g * BATCH + b) * NC) * 256 + dir * 128 + p;
            float xr = 0.f, xi = 0.f;
#pragma unroll 8
            for (int j = 0; j < 64; ++j) { const int c = dir == 0 ? seg * 64 + j : seg * 64 + 63 - j; const float er = E[rb + (size_t)c * 256], ei = E[rb + (size_t)c * 256 + 64];
                const float t = a.x * xr - a.y * xi + er; xi = a.x * xi + a.y * xr + ei; xr = t; }
            endst[seg * 128 + rec] = (f32x2){xr, xi};
            __syncthreads();
            float a64r = a.x, a64i = a.y;
#pragma unroll
            for (int s = 0; s < 6; ++s) { const float t = a64r * a64r - a64i * a64i; a64i = 2.f * a64r * a64i; a64r = t; }
            xr = 0.f; xi = 0.f;
            if (dir == 0) { for (int s = 0; s < seg; ++s) { const f32x2 e = endst[s * 128 + rec]; const float t = a64r * xr - a64i * xi + e.x; xi = a64r * xi + a64i * xr + e.y; xr = t; } }
            else { for (int s = 3; s > seg; --s) { const f32x2 e = endst[s * 128 + rec]; const float t = a64r * xr - a64i * xi + e.x; xi = a64r * xi + a64i * xr + e.y; xr = t; } }
#pragma unroll 8
            for (int j = 0; j < 64; ++j) { const int c = dir == 0 ? seg * 64 + j : seg * 64 + 63 - j; const float er = E[rb + (size_t)c * 256], ei = E[rb + (size_t)c * 256 + 64];
                XC[rb + (size_t)c * 256] = f2bf(xr); XC[rb + (size_t)c * 256 + 64] = f2bf(xi);
                const float t = a.x * xr - a.y * xi + er; xi = a.x * xi + a.y * xr + ei; xr = t; }
            __syncthreads();
        }
        if (BOTH(5)) GRID_BAR();
    }
    if (IN(6)) {
        pg8::Gemm g{(const char*)(ws + WS_XC), (const char*)(ws + WS_BT2), 256, 256, 256, 128, 0};
        pg8::SsmOrder S{2, G, bx, (size_t)BATCH * NC * 256 * 2, (size_t)NC * 256 * 2, (size_t)512 * 256 * 2, (size_t)256 * 256 * 2};
        EpiSsm2 E{(const bf16_t*)(ws + WS_YI), (bf16_t*)(ws + WS_Y)};
        pg8::gemm_phase<EpiSsm2, pg8::SsmOrder, true>(lds, g, S, E);
        if (BOTH(6)) GRID_BAR();
    }
    if (IN(7)) {
        pg8::Gemm g{(const char*)ws, (const char*)ws, 512, 512, 512, 128, 0}; pg8::MixOrder S{G, bx, WS_Y, WS_WGLU, WS_AO, WS_WOS};
        EpiMix E{(const bf16_t*)(ws + WS_Y), (bf16_t*)(ws + WS_YG), args.in[18], (const bf16_t*)(ws + WS_GA), (bf16_t*)(ws + WS_MRG)};
        pg8::gemm_phase<EpiMix, pg8::MixOrder, true>(lds, g, S, E);
        if (BOTH(7)) GRID_BAR();
    }
    if (IN(8)) {
        pg8::Gemm g{(const char*)(ws + WS_YG), (const char*)(ws + WS_WOS + (size_t)D * 512 * 2), 512, 512, 512, 128, 0}; pg8::PlainOrder S{M / 256, D / 256, G, bx, 512, 512};
        EpiSsmProj E{(const bf16_t*)(ws + WS_GS), (bf16_t*)(ws + WS_MRG)};
        pg8::gemm_phase<EpiSsmProj, pg8::PlainOrder, true>(lds, g, S, E);
        if (BOTH(8)) GRID_BAR();
    }
    if (IN(9)) {
        pg8::Gemm g{(const char*)(ws + WS_MRG), (const char*)(ws + WS_WOUT), D, D, D, 128, 0}; pg8::PlainOrder S{M / 256, D / 256, G, bx, D, D};
        EpiResid E{hout, hout, HB, ss2, 1.0f};
        pg8::gemm_phase<EpiResid, pg8::PlainOrder, true>(lds, g, S, E);
        if (BOTH(9)) GRID_BAR();
    }
    if (IN(10)) {
        { const float* pin = args.in[1]; bf16_t* PB = (bf16_t*)(ws + WS_PB);
          for (size_t i = (size_t)bx * 512 + tid; i < (size_t)M * PLE / 8; i += (size_t)G * 512) { const f32x4 a = *(const f32x4*)(pin + i * 8), b = *(const f32x4*)(pin + i * 8 + 4); *(u32x4*)(PB + i * 8) = pack8(a, b); } }
        pg8::Gemm g{(const char*)HB, (const char*)(ws + WS_WGU2), D, D, D, 128, 0}; pg8::PlainOrder S{M / 256, 2 * FF / 256, G, bx, D, D};
        EpiSwiglu E{(bf16_t*)(ws + WS_ACT), ss2};
        pg8::gemm_phase<EpiSwiglu, pg8::PlainOrder, true>(lds, g, S, E);
        if (BOTH(10)) GRID_BAR();
    }
    if (IN(11)) {
        { pg8::Gemm g{(const char*)(ws + WS_ACT), (const char*)(ws + WS_WD2), FF, FF, FF, 128, 0}; pg8::PlainOrder S{M / 256, D / 256, G, bx, FF, FF};
          EpiResid E{hout, hout, HB, ss3, 0.5f};
          pg8::gemm_phase<EpiResid, pg8::PlainOrder, true>(lds, g, S, E); }
        { pg8::Gemm g{(const char*)(ws + WS_PB), (const char*)(ws + WS_WPP), PLE, PLE, PLE, 128, 0}; pg8::PlainOrder S{M / 256, D / 256, G, bx, PLE, PLE};
          EpiStoreF32 E{(float*)(ws + WS_PROJ)};
          pg8::gemm_phase<EpiStoreF32, pg8::PlainOrder, true>(lds, g, S, E); }
        if (BOTH(11)) GRID_BAR();
    }
    if (IN(12)) {
        pg8::Gemm g{(const char*)HB, (const char*)(ws + WS_WPG), D, D, D, 128, 0}; pg8::PlainOrder S{M / 256, D / 256, G, bx, D, D};
        EpiPleGate E{hout, (const float*)(ws + WS_PROJ), ss3};
        pg8::gemm_phase<EpiPleGate, pg8::PlainOrder, true>(lds, g, S, E);
        if (BOTH(12)) GRID_BAR();
    }
    if (IN(13)) {
        const float* gn = args.in[29];
        for (int m = gw; m < M; m += NGW) {
            f32x4* xr = (f32x4*)(hout + (size_t)m * D) + lane; f32x4 v[4]; float s = 0.f;
#pragma unroll
            for (int j = 0; j < 4; ++j) { v[j] = xr[64 * j]; s += (v[j][0] * v[j][0] + v[j][1] * v[j][1]) + (v[j][2] * v[j][2] + v[j][3] * v[j][3]); }
            const float r = rinv_f(wave_sum(s));
#pragma unroll
            for (int j = 0; j < 4; ++j) { const f32x4 gg = ((const f32x4*)gn)[lane + 64 * j]; xr[64 * j] = v[j] * r * gg; }
        }
    }
#undef IN
#undef BOTH
}

#if MK_SCAFFOLD && MK_MODE == 0
__global__ void __launch_bounds__(64) sc_natten(const bf16_t* __restrict__ q, const bf16_t* __restrict__ k, const bf16_t* __restrict__ v, const float* __restrict__ rpb, bf16_t* __restrict__ out) {
    const int idx = blockIdx.x * 64 + threadIdx.x; const int tok = idx >> 3, h = idx & 7, b = tok / SEQ, s = tok % SEQ, r = s / GW, c = s % GW;
    int rs = r - 4; rs = rs < 0 ? 0 : (rs > ROWS - 8 ? ROWS - 8 : rs);
    int cs = c - 8; cs = cs < 0 ? 0 : (cs > GW - 16 ? GW - 16 : cs);
    float qv[HD];
#pragma unroll
    for (int e = 0; e < HD; ++e) qv[e] = bf2f(q[(size_t)tok * AW + h * HD + e]);
    float mx = -1e30f;
    for (int j = 0; j < 8; ++j) for (int w = 0; w < 16; ++w) { const size_t kt = (size_t)b * SEQ + (rs + j) * GW + cs + w; const bf16_t* kp = k + kt * AW + h * HD;
        float d = 0.f;
#pragma unroll
        for (int e = 0; e < HD; ++e) d = fmaf(qv[e], bf2f(kp[e]), d);
        mx = fmaxf(mx, d + rpb[(h * 15 + (rs + j - r + 7)) * 31 + (cs + w - c + 15)]); }
    float o[HD];
#pragma unroll
    for (int e = 0; e < HD; ++e) o[e] = 0.f;
    float sum = 0.f;
    for (int j = 0; j < 8; ++j) for (int w = 0; w < 16; ++w) { const size_t kt = (size_t)b * SEQ + (rs + j) * GW + cs + w; const bf16_t* kp = k + kt * AW + h * HD; const bf16_t* vp = v + kt * AW + h * HD;
        float d = 0.f;
#pragma unroll
        for (int e = 0; e < HD; ++e) d = fmaf(qv[e], bf2f(kp[e]), d);
        const float pe = expf(d + rpb[(h * 15 + (rs + j - r + 7)) * 31 + (cs + w - c + 15)] - mx); sum += pe;
#pragma unroll
        for (int e = 0; e < HD; ++e) o[e] = fmaf(pe, bf2f(vp[e]), o[e]); }
    const float inv = 1.0f / sum;
#pragma unroll
    for (int e = 0; e < HD; ++e) out[(size_t)tok * AW + h * HD + e] = f2bf(o[e] * inv);
}
__global__ void __launch_bounds__(64) sc_s5(const bf16_t* __restrict__ ub, const float* __restrict__ lam_re, const float* __restrict__ lam_im, const float* __restrict__ log_dt,
                                            const float* __restrict__ b_re, const float* __restrict__ b_im, const float* __restrict__ c_re, const float* __restrict__ c_im, float* __restrict__ yf, int dir) {
    __shared__ float xr[64][65], xi[64][65], cr[16][64], ci[16][64], us[64][16];
    const int g = blockIdx.x, b = blockIdx.y, p = threadIdx.x; const int gp = (dir * NG + g) * NP + p;
    const double lr = fmin((double)lam_re[gp], -1e-4), li = (double)lam_im[gp], dt = exp((double)log_dt[dir * NG + g]);
    const double er = exp(lr * dt), ar = er * cos(li * dt), ai = er * sin(li * dt);
    const double nr = ar - 1.0, ni = ai, den = lr * lr + li * li; const double fr = (nr * lr + ni * li) / den, fi = (ni * lr - nr * li) / den;
    float bbr[16], bbi[16];
#pragma unroll
    for (int i = 0; i < 16; ++i) { const double br = b_re[(size_t)gp * GC + i], bi = b_im[(size_t)gp * GC + i]; bbr[i] = (float)(fr * br - fi * bi); bbi[i] = (float)(fr * bi + fi * br); }
    for (int o = 0; o < 16; ++o) { cr[o][p] = c_re[((size_t)(dir * NG + g) * GC + o) * NP + p]; ci[o][p] = c_im[((size_t)(dir * NG + g) * GC + o) * NP + p]; }
    const float far = (float)ar, fai = (float)ai; float sr = 0.f, si = 0.f;
    for (int blk = 0; blk < SEQ / 64; ++blk) {
        __syncthreads();
        for (int e = p; e < 64 * 16; e += 64) { const int tt = e >> 4, i = e & 15; const int t = dir ? (SEQ - 1 - (blk * 64 + tt)) : (blk * 64 + tt); us[tt][i] = bf2f(ub[((size_t)b * SEQ + t) * SW + g * GC + i]); }
        __syncthreads();
        for (int tt = 0; tt < 64; ++tt) { float br = 0.f, bi = 0.f;
#pragma unroll
            for (int i = 0; i < 16; ++i) { const float u = us[tt][i]; br = fmaf(bbr[i], u, br); bi = fmaf(bbi[i], u, bi); }
            const float n1 = far * sr - fai * si + br, n2 = far * si + fai * sr + bi; sr = n1; si = n2; xr[tt][p] = sr; xi[tt][p] = si; }
        __syncthreads();
        for (int e = p; e < 64 * 16; e += 64) { const int tt = e >> 4, o = e & 15; float a = 0.f;
            for (int q = 0; q < 64; ++q) a += xr[tt][q] * cr[o][q] - xi[tt][q] * ci[o][q];
            const int t = dir ? (SEQ - 1 - (blk * 64 + tt)) : (blk * 64 + tt); float* d = yf + ((size_t)b * SEQ + t) * SW + g * GC + o; if (dir) *d += a; else *d = a; }
    }
}
__global__ void sc_comb(const bf16_t* __restrict__ ub, const float* __restrict__ dsk, const float* __restrict__ yf, bf16_t* __restrict__ y) {
    size_t i = (size_t)blockIdx.x * blockDim.x + threadIdx.x; const int c = (int)(i % SW);
    y[i] = f2bf(gelu_tanh_f(dsk[c] * bf2f(ub[i]) + yf[i]));
}
#endif

#ifdef MK_TRUNC
__global__ void dump_k(const unsigned short* __restrict__ src, float* __restrict__ out, size_t n) {
    size_t i = (size_t)blockIdx.x * blockDim.x + threadIdx.x; if (i < n) out[i] = (float)src[i];
}
#endif
extern "C" void kernel_launch(void* const* d_in, const int* in_sizes, int n_in, void* d_out, int out_size, void* d_ws, size_t ws_size, hipStream_t stream) {
    static int grid = 0;
    if (grid == 0) {
        if (n_in != 30 || out_size != M * D || ws_size < WS_END) { fprintf(stderr, "kernel_launch: unexpected shapes (n_in %d out %d ws %zu)\n", n_in, out_size, ws_size); grid = -1; return; }
        int dev = 0, cus = 0;
        if (hipGetDevice(&dev) != hipSuccess || hipDeviceGetAttribute(&cus, hipDeviceAttributeMultiprocessorCount, dev) != hipSuccess) { grid = -1; return; }
        if (hipFuncSetAttribute((const void*)mk_fwd, hipFuncAttributeMaxDynamicSharedMemorySize, LDS_BYTES) != hipSuccess) { fprintf(stderr, "kernel_launch: hipFuncSetAttribute failed\n"); grid = -1; return; }
        (void)hipGetLastError();
        grid = cus;
    }
    if (grid < 0) return;
    (void)hipMemsetAsync((char*)d_ws + WS_CTL, 0, CTL_ZERO_BYTES, stream);
    Args a{};
    for (int i = 0; i < 30; ++i) a.in[i] = (const float*)d_in[i];
    a.out = (float*)d_out; a.ws = (unsigned char*)d_ws;
#if MK_MODE == 1
    a.ph_lo = 0; a.ph_hi = N_PHASES;
#ifdef MK_TRUNC
    a.ph_hi = MK_TRUNC + 1;
#endif
    hipLaunchKernelGGL(mk_fwd, dim3(grid), dim3(512), LDS_BYTES, stream, a);
#ifdef MK_TRUNC
    hipLaunchKernelGGL(dump_k, dim3((unsigned)((size_t)M * D / 256)), dim3(256), 0, stream, (const unsigned short*)((unsigned char*)d_ws + (size_t)MK_DUMP_MIB * MiB), (float*)d_out, (size_t)M * D);
#endif
#else
    unsigned char* ws = (unsigned char*)d_ws;
    for (int ph = 0; ph < N_PHASES; ++ph) {
#ifdef MK_TRUNC
        if (ph > MK_TRUNC) { hipLaunchKernelGGL(dump_k, dim3((unsigned)((size_t)M * D / 256)), dim3(256), 0, stream, (const unsigned short*)(ws + (size_t)MK_DUMP_MIB * MiB), (float*)d_out, (size_t)M * D); break; }
#endif
#if MK_SCAFFOLD
        if (ph == 4) {
            hipLaunchKernelGGL(sc_natten, dim3(M * NHEAD / 64), dim3(64), 0, stream, (const bf16_t*)(ws + WS_Q), (const bf16_t*)(ws + WS_K), (const bf16_t*)(ws + WS_V), (const float*)d_in[8], (bf16_t*)(ws + WS_AO));
            for (int dir = 0; dir < 2; ++dir)
                hipLaunchKernelGGL(sc_s5, dim3(NG, BATCH), dim3(64), 0, stream, (const bf16_t*)(ws + WS_U), (const float*)d_in[9], (const float*)d_in[10], (const float*)d_in[11], (const float*)d_in[12], (const float*)d_in[13],
                                   (const float*)d_in[14], (const float*)d_in[15], (float*)(ws + WS_YF), dir);
            hipLaunchKernelGGL(sc_comb, dim3((unsigned)((size_t)M * SW / 256)), dim3(256), 0, stream, (const bf16_t*)(ws + WS_U), (const float*)d_in[16], (const float*)(ws + WS_YF), (bf16_t*)(ws + WS_Y));
            continue;
        }
        if (ph == 5 || ph == 6) continue;
#endif
        a.ph_lo = ph; a.ph_hi = ph + 1;
        hipLaunchKernelGGL(mk_fwd, dim3(grid), dim3(512), LDS_BYTES, stream, a);
    }
#endif
}
```

```cpp
#include <hip/hip_runtime.h>
#include <cstdio>
#include <cstdint>

#ifndef MK_MODE
#define MK_MODE 1
#endif
#ifndef MK_SCAFFOLD
#define MK_SCAFFOLD 0
#endif
#ifndef PH_MASK
#define PH_MASK 0x3fff
#endif

#define LAS __attribute__((address_space(3)))
#define GAS __attribute__((address_space(1)))
typedef unsigned short bf16_t;
typedef short bf16x8 __attribute__((ext_vector_type(8)));
typedef float f32x4 __attribute__((ext_vector_type(4)));
typedef float f32x2 __attribute__((ext_vector_type(2)));
typedef unsigned u32x4 __attribute__((ext_vector_type(4)));
typedef unsigned u32x2 __attribute__((ext_vector_type(2)));

constexpr int BATCH = 4, SEQ = 8192, D = 1024, M = BATCH * SEQ, FF = 2816, NIN = 4096, AW = 512, SW = 512, PLE = 256;
constexpr int NHEAD = 8, HD = 64, GW = 64, ROWS = SEQ / GW;
constexpr int NG = 32, GC = 16, NP = 64, TC = 32, NC = SEQ / TC;
constexpr float RMS_EPS = 1e-6f;

constexpr size_t MiB = 1u << 20;
constexpr size_t WS_CTL = 0, CTL_ZERO_BYTES = 2 * MiB;
constexpr size_t WS_SS = 1 * MiB;
constexpr size_t WS_WGU1 = 2 * MiB, WS_WD1 = 13 * MiB, WS_WIN = 19 * MiB, WS_WGLU = 27 * MiB, WS_WOS = 28 * MiB, WS_WOUT = 30 * MiB;
constexpr size_t WS_WGU2 = 32 * MiB, WS_WD2 = 43 * MiB, WS_WPG = 49 * MiB, WS_WPP = 51 * MiB;
constexpr size_t WS_BT1 = 52 * MiB, WS_BT2 = 76 * MiB, WS_AT = 84 * MiB;
constexpr size_t WS_HB = 86 * MiB;
constexpr size_t WS_AO = WS_HB, WS_YG = WS_HB + 32 * MiB;
constexpr size_t WS_BIG = 150 * MiB;
constexpr size_t WS_ACT = WS_BIG;
constexpr size_t WS_PROJ = 342 * MiB;
constexpr size_t WS_PB = 486 * MiB;
constexpr size_t WS_Q = 150 * MiB, WS_K = 182 * MiB, WS_V = 214 * MiB, WS_U = 246 * MiB, WS_GA = 278 * MiB, WS_GS = 342 * MiB;
constexpr size_t WS_YI = 406 * MiB, WS_E = 438 * MiB, WS_XC = 470 * MiB;
constexpr size_t WS_Y = WS_V, WS_MRG = WS_Q;
constexpr size_t WS_YF = 406 * MiB;
constexpr size_t WS_END = 512 * MiB;
constexpr int CW_TMO = 0, CW_BAR = 4096;

constexpr int RING_BYTES = 131072, LDS_BYTES = 147456, MISC_OFF = LDS_BYTES - 256;

typedef __bf16 bf16x2_t __attribute__((ext_vector_type(2)));
__device__ __forceinline__ unsigned cvt_pk_bf16(float lo, float hi) { const f32x2 v = {lo, hi}; const bf16x2_t b = __builtin_convertvector(v, bf16x2_t); return __builtin_bit_cast(unsigned, b); }
__device__ __forceinline__ float bf_lo(unsigned w) { return __uint_as_float(w << 16); }
__device__ __forceinline__ float bf_hi(unsigned w) { return __uint_as_float(w & 0xffff0000u); }
__device__ __forceinline__ float bf2f(bf16_t b) { return __uint_as_float((unsigned)b << 16); }
__device__ __forceinline__ bf16_t f2bf(float f) { unsigned u = __float_as_uint(f); return (bf16_t)((u + 0x7fffu + ((u >> 16) & 1u)) >> 16); }
__device__ __forceinline__ float fsigmoid(float x) { return __builtin_amdgcn_rcpf(1.0f + __builtin_amdgcn_exp2f(-1.4426950408889634f * x)); }
__device__ __forceinline__ float gelu_tanh_f(float x) { return x * fsigmoid(1.5957691216057308f * (x + 0.044715f * x * x * x)); }
typedef unsigned long long u64;
constexpr float SS_SCALE = 1048576.0f;
__device__ __forceinline__ float rinv_of(u64 ss) { return 1.0f / sqrtf((float)ss * (1.0f / (SS_SCALE * D)) + RMS_EPS); }
__device__ __forceinline__ float rinv_f(float ss) { return 1.0f / sqrtf(ss * (1.0f / D) + RMS_EPS); }
__device__ __forceinline__ u64 ss_fix(float s) { return (u64)(s * SS_SCALE + 0.5f); }
__device__ __forceinline__ u32x4 pack8(f32x4 a, f32x4 b) { u32x4 w; w.x = cvt_pk_bf16(a[0], a[1]); w.y = cvt_pk_bf16(a[2], a[3]); w.z = cvt_pk_bf16(b[0], b[1]); w.w = cvt_pk_bf16(b[2], b[3]); return w; }
__device__ __forceinline__ void unpack8(u32x4 w, f32x4& a, f32x4& b) { a = (f32x4){bf_lo(w.x), bf_hi(w.x), bf_lo(w.y), bf_hi(w.y)}; b = (f32x4){bf_lo(w.z), bf_hi(w.z), bf_lo(w.w), bf_hi(w.w)}; }
__device__ __forceinline__ float sq8(f32x4 a, f32x4 b) { return (a[0] * a[0] + a[1] * a[1]) + (a[2] * a[2] + a[3] * a[3]) + (b[0] * b[0] + b[1] * b[1]) + (b[2] * b[2] + b[3] * b[3]); }

namespace pg8 {
constexpr int BM = 256, BK = 64, HALF = 128, HTB = HALF * BK * 2, STAGE_BYTES = 8 * HTB, NXCD = 8, WGM = 8;
__host__ __device__ __forceinline__ int lds_byte(int r, int c) { const int st = (r >> 4) * 2 + (c >> 5), rr = r & 15, cc = c & 31, ob = rr * 64 + cc * 2; return st * 1024 + (ob ^ (((ob >> 9) & 1) << 5)); }
__host__ __device__ __forceinline__ void stage_rc(int b, int& R, int& C) { const int st = b / 1024, sb = b % 1024, swz = sb ^ (((sb >> 9) & 1) << 5); R = (st >> 1) * 16 + swz / 64; C = (st & 1) * 32 + (swz % 64) / 2; }
__host__ __device__ __forceinline__ int perm32(int rho) { const int n = rho >> 4, i = rho & 15; return 8 * (i >> 2) + 4 * n + (i & 3); }

struct Unit { int pm, pn, grp; size_t aoff, boff; };
struct Gemm { const char* A; const char* Bt; int K; unsigned lda, ldb; unsigned kstepA; int amap; };

__device__ __forceinline__ bool static_tile(int L, int nM, int nN, int& pm, int& pn) {
    const int nwg = nM * nN; if (L >= nwg) return false;
    int wgid = L; { const int q = nwg / NXCD, r = nwg % NXCD, xcd = wgid % NXCD, off = wgid / NXCD; wgid = (xcd < r ? xcd * (q + 1) : r * (q + 1) + (xcd - r) * q) + off; }
    const int nig = WGM * nN, gid = wgid / nig, fm = gid * WGM, gsz = (nM - fm) < WGM ? (nM - fm) : WGM;
    pm = fm + ((wgid % nig) % gsz); pn = (wgid % nig) / gsz; return true;
}
struct PlainOrder {
    int nM, nN, G, c; unsigned lda, ldb;
    __device__ __forceinline__ bool next(int i, Unit& u) const {
        if (!static_tile(i * G + c, nM, nN, u.pm, u.pn)) return false;
        u.grp = 0; u.aoff = (size_t)u.pm * 256 * lda * 2; u.boff = (size_t)u.pn * 256 * ldb * 2; return true; }
};
struct MixOrder {
    int G, c; size_t a0, b0, a1, b1;
    __device__ __forceinline__ bool next(int i, Unit& u) const {
        const int L = i * G + c; constexpr int NGLU = (M / 256) * (SW / 256);
        if (L < NGLU) { if (!static_tile(L, M / 256, SW / 256, u.pm, u.pn)) return false; u.grp = 0; u.aoff = a0 + (size_t)u.pm * 256 * 512 * 2; u.boff = b0 + (size_t)u.pn * 256 * 512 * 2; return true; }
        if (!static_tile(L - NGLU, M / 256, D / 256, u.pm, u.pn)) return false; u.grp = 1; u.aoff = a1 + (size_t)u.pm * 256 * 512 * 2; u.boff = b1 + (size_t)u.pn * 256 * 512 * 2; return true; }
};
struct SsmOrder {
    int npn, G, c; size_t a_g, a_b, b_g, b_pn;
    __device__ __forceinline__ bool next(int i, Unit& u) const {
        const int L = i * G + c; if (L >= NG * BATCH * npn) return false;
        const int g = L / (BATCH * npn), rem = L % (BATCH * npn); u.grp = g; u.pn = rem / BATCH; u.pm = rem % BATCH;
        u.aoff = (size_t)g * a_g + (size_t)u.pm * a_b; u.boff = (size_t)g * b_g + (size_t)u.pn * b_pn; return true; }
};

template <class Epi, class Sched, bool ALIGN_EPI>
__device__ __forceinline__ void gemm_phase(LAS unsigned char* lds, const Gemm g, const Sched& S, const Epi& E) {
    const int tid = threadIdx.x, wid = __builtin_amdgcn_readfirstlane(tid >> 6), lane = tid & 63, wr = wid >> 2, wc = wid & 3, fr = lane & 15, fq = lane >> 4;
    int Kop = g.K; asm volatile("" : "+s"(Kop));
    const int nt = Kop / BK;
    unsigned voffA[2], voffB[2];
#pragma unroll
    for (int i = 0; i < 2; ++i) { int R, C; stage_rc(tid * 16 + i * 8192, R, C); const int Rb = (R & ~31) + perm32(R & 31);
        const int Ca = g.amap ? ((C >> 4) * 512 + (C & 15)) : C;
        voffA[i] = (unsigned)(R * (int)g.lda + Ca) * 2u; voffB[i] = (unsigned)(Rb * (int)g.ldb + C) * 2u; }
    const size_t kstepA = (size_t)g.kstepA, kstepB = (size_t)(BK * 2);
    const size_t hstepA = (size_t)HALF * g.lda * 2, hstepB = (size_t)HALF * g.ldb * 2;
    const unsigned ldsw = (unsigned)wid * 1024u;
    const int aoff = lds_byte(wr * 64 + fr, fq * 8), boff = lds_byte(wc * 32 + fr, fq * 8);
#define PG8_SA(b, h) (((b) * 2 + (h)) * HTB)
#define PG8_SB(b, h) ((4 + (b) * 2 + (h)) * HTB)
#define PG8_STAGE(bufoff, gbase, voff) do { _Pragma("unroll") for (int _i = 0; _i < 2; ++_i) \
        __builtin_amdgcn_global_load_lds((const unsigned*)((const char*)(gbase) + (voff)[_i]), (LAS unsigned*)(lds + (bufoff) + ldsw + _i * 8192), 16, 0, 0); } while (0)
#define PG8_LDA(dst, b, h) do { _Pragma("unroll") for (int m = 0; m < 4; ++m) _Pragma("unroll") for (int k = 0; k < 2; ++k) dst[m][k] = *(const LAS bf16x8*)(lds + PG8_SA(b, h) + aoff + m * 2048 + k * 1024); } while (0)
#define PG8_LDB(dst, b, h) do { _Pragma("unroll") for (int n = 0; n < 2; ++n) _Pragma("unroll") for (int k = 0; k < 2; ++k) dst[n][k] = *(const LAS bf16x8*)(lds + PG8_SB(b, h) + boff + n * 2048 + k * 1024); } while (0)
#define PG8_MMA(ai, bj, At, Bt) do { __builtin_amdgcn_s_setprio(1); _Pragma("unroll") for (int m = 0; m < 4; ++m) _Pragma("unroll") for (int n = 0; n < 2; ++n) _Pragma("unroll") for (int k = 0; k < 2; ++k) \
        acc[ai][bj][m][n] = __builtin_amdgcn_mfma_f32_16x16x32_bf16(Bt[n][k], At[m][k], acc[ai][bj][m][n], 0, 0, 0); __builtin_amdgcn_s_setprio(0); } while (0)
#define PG8_WAIT_V(n) asm volatile("s_waitcnt vmcnt(" #n ")" ::: "memory")
#define PG8_WAIT_L(n) asm volatile("s_waitcnt lgkmcnt(" #n ")" ::: "memory")
#define PG8_BAR __builtin_amdgcn_s_barrier()
#define PG8_SCHED __builtin_amdgcn_sched_barrier(0)
    Unit cur, nxt; int ui = 0;
    if (!S.next(0, cur)) return;
    f32x4 acc[2][2][4][2];
#pragma unroll
    for (int a = 0; a < 2; ++a)
#pragma unroll
        for (int b = 0; b < 2; ++b)
#pragma unroll
            for (int m = 0; m < 4; ++m)
#pragma unroll
                for (int n = 0; n < 2; ++n) acc[a][b][m][n] = (f32x4){0.f, 0.f, 0.f, 0.f};
    bf16x8 At[4][2], B0[2][2], B1[2][2];
    const char* cA = g.A + cur.aoff; const char* cB = g.Bt + cur.boff;
    PG8_STAGE(PG8_SB(0, 0), cB, voffB); PG8_STAGE(PG8_SB(0, 1), cB + hstepB, voffB); PG8_STAGE(PG8_SA(0, 0), cA, voffA); PG8_STAGE(PG8_SA(0, 1), cA + hstepA, voffA);
    if (wr == 1) PG8_BAR;
    PG8_WAIT_V(2); PG8_BAR;
    PG8_STAGE(PG8_SB(1, 0), cB + kstepB, voffB); PG8_STAGE(PG8_SA(1, 0), cA + kstepA, voffA); PG8_STAGE(PG8_SB(1, 1), cB + hstepB + kstepB, voffB);
    PG8_WAIT_V(6); PG8_BAR;
    for (;;) {
        const bool has_next = S.next(ui + 1, nxt);
        const char* nA = has_next ? g.A + nxt.aoff : cA; const char* nB = has_next ? g.Bt + nxt.boff : cB;
        for (int t = 0; t < nt; t += 2) {
            const bool last = (t == nt - 2);
            const char* a1 = cA + (size_t)(t + 1) * kstepA;
            const char* a2 = last ? nA : cA + (size_t)(t + 2) * kstepA; const char* b2 = last ? nB : cB + (size_t)(t + 2) * kstepB;
            const char* a3 = a2 + kstepA; const char* b3 = b2 + kstepB;
            PG8_LDB(B0, 0, 0); PG8_LDB(B1, 0, 1); PG8_SCHED; PG8_LDA(At, 0, 0); PG8_STAGE(PG8_SA(1, 1), a1 + hstepA, voffA);
            PG8_WAIT_V(8); PG8_WAIT_L(0); PG8_BAR; PG8_MMA(0, 0, At, B0); PG8_MMA(0, 1, At, B1); PG8_BAR; PG8_SCHED;
            PG8_LDA(At, 0, 1); PG8_STAGE(PG8_SB(0, 0), b2, voffB); PG8_STAGE(PG8_SB(0, 1), b2 + hstepB, voffB); PG8_STAGE(PG8_SA(0, 0), a2, voffA);
            PG8_WAIT_V(8); PG8_WAIT_L(0); PG8_BAR; PG8_MMA(1, 0, At, B0); PG8_MMA(1, 1, At, B1); PG8_BAR; PG8_SCHED;
            PG8_LDB(B0, 1, 0); PG8_LDB(B1, 1, 1); PG8_SCHED; PG8_LDA(At, 1, 0); PG8_STAGE(PG8_SA(0, 1), a2 + hstepA, voffA);
            PG8_WAIT_V(8); PG8_WAIT_L(0); PG8_BAR; PG8_MMA(0, 0, At, B0); PG8_MMA(0, 1, At, B1); PG8_BAR; PG8_SCHED;
            PG8_LDA(At, 1, 1); PG8_STAGE(PG8_SB(1, 0), b3, voffB); PG8_STAGE(PG8_SB(1, 1), b3 + hstepB, voffB); PG8_STAGE(PG8_SA(1, 0), a3, voffA);
            PG8_WAIT_V(8); PG8_WAIT_L(0); PG8_BAR; PG8_MMA(1, 0, At, B0); PG8_MMA(1, 1, At, B1); PG8_BAR; PG8_SCHED;
        }
        if constexpr (ALIGN_EPI) { if (wr == 0) PG8_BAR; }
        E(acc, cur, wr, wc, fr, fq);
        if (!has_next) break;
#pragma unroll
        for (int a = 0; a < 2; ++a)
#pragma unroll
            for (int b = 0; b < 2; ++b)
#pragma unroll
                for (int m = 0; m < 4; ++m)
#pragma unroll
                    for (int n = 0; n < 2; ++n) acc[a][b][m][n] = (f32x4){0.f, 0.f, 0.f, 0.f};
        cur = nxt; cA = nA; cB = nB; ++ui;
        if constexpr (ALIGN_EPI) { if (wr == 1) PG8_BAR; }
    }
    PG8_WAIT_V(0);
    if constexpr (!ALIGN_EPI) { if (wr == 0) PG8_BAR; }
    PG8_BAR;
#undef PG8_SA
#undef PG8_SB
#undef PG8_STAGE
#undef PG8_LDA
#undef PG8_LDB
#undef PG8_MMA
#undef PG8_WAIT_V
#undef PG8_WAIT_L
#undef PG8_BAR
#undef PG8_SCHED
}
}

typedef f32x4 AccT[2][2][4][2];
using pg8::Unit;
struct EpiSwiglu { bf16_t* act; const u64* ss;
    __device__ __forceinline__ void operator()(const AccT& acc, const Unit& u, int wr, int wc, int fr, int fq) const {
        const int row0 = u.pm * 256 + wr * 64 + fr, col0 = u.pn * 128 + wc * 32 + 8 * fq;
#pragma unroll
        for (int ai = 0; ai < 2; ++ai)
#pragma unroll
            for (int m = 0; m < 4; ++m) { const int row = row0 + ai * 128 + m * 16; const float rr = rinv_of(ss[row]);
                f32x4 o[2];
#pragma unroll
                for (int n = 0; n < 2; ++n)
#pragma unroll
                    for (int e = 0; e < 4; ++e) { const float gv = acc[ai][0][m][n][e] * rr, uv = acc[ai][1][m][n][e] * rr; o[n][e] = gv * fsigmoid(gv) * uv; }
                *(u32x4*)(act + (size_t)row * FF + col0) = pack8(o[0], o[1]); }
    }
};
struct EpiResid { const float* base; float* out; bf16_t* hb; u64* ssn; float alpha;
    __device__ __forceinline__ void operator()(const AccT& acc, const Unit& u, int wr, int wc, int fr, int fq) const {
        const int row0 = u.pm * 256 + wr * 64 + fr, col0 = u.pn * 256 + wc * 32 + 8 * fq;
#pragma unroll
        for (int ai = 0; ai < 2; ++ai)
#pragma unroll
            for (int m = 0; m < 4; ++m) { const int row = row0 + ai * 128 + m * 16; float sq = 0.f;
#pragma unroll
                for (int bj = 0; bj < 2; ++bj) { const size_t off = (size_t)row * D + col0 + bj * 128;
                    const f32x4 b0 = *(const f32x4*)(base + off), b1 = *(const f32x4*)(base + off + 4);
                    const f32x4 h0 = b0 + alpha * acc[ai][bj][m][0], h1 = b1 + alpha * acc[ai][bj][m][1];
                    *(f32x4*)(out + off) = h0; *(f32x4*)(out + off + 4) = h1; *(u32x4*)(hb + off) = pack8(h0, h1); sq += sq8(h0, h1); }
                sq += __shfl_xor(sq, 16); sq += __shfl_xor(sq, 32);
                if (fq == 0) atomicAdd(ssn + row, ss_fix(sq));
                asm volatile("" ::: "memory"); }
    }
};
struct EpiWin { bf16_t* qkvu; bf16_t* gg; const u64* ss;
    __device__ __forceinline__ void operator()(const AccT& acc, const Unit& u, int wr, int wc, int fr, int fq) const {
        const int row0 = u.pm * 256 + wr * 64 + fr; const int pn = u.pn;
        if (pn < 8) { const int t = pn >> 1; bf16_t* dst = qkvu + (size_t)t * M * 512; const int col0 = (pn & 1) * 256 + wc * 32 + 8 * fq; const float sc = (t == 0) ? 0.125f : 1.0f;
#pragma unroll
            for (int ai = 0; ai < 2; ++ai)
#pragma unroll
                for (int m = 0; m < 4; ++m) { const int row = row0 + ai * 128 + m * 16; const float rr = rinv_of(ss[row]) * sc;
#pragma unroll
                    for (int bj = 0; bj < 2; ++bj) *(u32x4*)(dst + (size_t)row * 512 + col0 + bj * 128) = pack8(acc[ai][bj][m][0] * rr, acc[ai][bj][m][1] * rr); }
        } else { const int w = (pn - 8) >> 2; bf16_t* dst = gg + (size_t)w * M * D; const int col0 = ((pn - 8) & 3) * 256 + wc * 32 + 8 * fq;
#pragma unroll
            for (int ai = 0; ai < 2; ++ai)
#pragma unroll
                for (int m = 0; m < 4; ++m) { const int row = row0 + ai * 128 + m * 16; const float rr = rinv_of(ss[row]);
#pragma unroll
                    for (int bj = 0; bj < 2; ++bj) { f32x4 o[2];
#pragma unroll
                        for (int n = 0; n < 2; ++n)
#pragma unroll
                            for (int e = 0; e < 4; ++e) o[n][e] = fsigmoid(acc[ai][bj][m][n][e] * rr);
                        *(u32x4*)(dst + (size_t)row * D + col0 + bj * 128) = pack8(o[0], o[1]); } }
        }
    }
};
struct EpiSsm1 { bf16_t* yi; float* E;
    __device__ __forceinline__ void operator()(const AccT& acc, const Unit& u, int wr, int wc, int fr, int fq) const {
        const int g = u.grp, b = u.pm;
#pragma unroll
        for (int ai = 0; ai < 2; ++ai)
#pragma unroll
            for (int m = 0; m < 4; ++m) { const int c = ai * 128 + wr * 64 + m * 16 + fr;
#pragma unroll
                for (int bj = 0; bj < 2; ++bj) { const int n = bj * 128 + wc * 32 + 8 * fq;
                    if (u.pn < 2) { const int nn = u.pn * 256 + n, tau = nn >> 4, o = nn & 15;
                        *(u32x4*)(yi + ((size_t)b * SEQ + c * TC + tau) * SW + g * GC + o) = pack8(acc[ai][bj][m][0], acc[ai][bj][m][1]); }
                    else { float* e = E + ((size_t)(g * BATCH + b) * NC + c) * 256 + n; *(f32x4*)e = acc[ai][bj][m][0]; *(f32x4*)(e + 4) = acc[ai][bj][m][1]; } } }
    }
};
struct EpiSsm2 { const bf16_t* yi; bf16_t* y;
    __device__ __forceinline__ void operator()(const AccT& acc, const Unit& u, int wr, int wc, int fr, int fq) const {
        const int g = u.grp, b = u.pm;
#pragma unroll
        for (int ai = 0; ai < 2; ++ai)
#pragma unroll
            for (int m = 0; m < 4; ++m) { const int c = ai * 128 + wr * 64 + m * 16 + fr;
#pragma unroll
                for (int bj = 0; bj < 2; ++bj) { const int nn = u.pn * 256 + bj * 128 + wc * 32 + 8 * fq, tau = nn >> 4, o = nn & 15;
                    const size_t off = ((size_t)b * SEQ + c * TC + tau) * SW + g * GC + o;
                    f32x4 i0, i1; unpack8(*(const u32x4*)(yi + off), i0, i1); i0 += acc[ai][bj][m][0]; i1 += acc[ai][bj][m][1];
#pragma unroll
                    for (int e = 0; e < 4; ++e) { i0[e] = gelu_tanh_f(i0[e]); i1[e] = gelu_tanh_f(i1[e]); }
                    *(u32x4*)(y + off) = pack8(i0, i1); }
                asm volatile("" ::: "memory"); }
    }
};
struct EpiMix { const bf16_t* y; bf16_t* yg; const float* bias; const bf16_t* ga; bf16_t* mrg;
    __device__ __forceinline__ void operator()(const AccT& acc, const Unit& u, int wr, int wc, int fr, int fq) const {
        const int row0 = u.pm * 256 + wr * 64 + fr, col0 = u.pn * 256 + wc * 32 + 8 * fq;
        if (u.grp == 0) {
#pragma unroll
            for (int bj = 0; bj < 2; ++bj) { const f32x4 bv0 = *(const f32x4*)(bias + col0 + bj * 128), bv1 = *(const f32x4*)(bias + col0 + bj * 128 + 4);
#pragma unroll
                for (int ai = 0; ai < 2; ++ai)
#pragma unroll
                    for (int m = 0; m < 4; ++m) { const size_t off = (size_t)(row0 + ai * 128 + m * 16) * SW + col0 + bj * 128;
                        f32x4 y0, y1; unpack8(*(const u32x4*)(y + off), y0, y1); const f32x4 t0 = acc[ai][bj][m][0] + bv0, t1 = acc[ai][bj][m][1] + bv1;
#pragma unroll
                        for (int e = 0; e < 4; ++e) { y0[e] *= fsigmoid(t0[e]); y1[e] *= fsigmoid(t1[e]); }
                        *(u32x4*)(yg + off) = pack8(y0, y1);
                        asm volatile("" ::: "memory"); } }
        } else {
#pragma unroll
            for (int ai = 0; ai < 2; ++ai)
#pragma unroll
                for (int m = 0; m < 4; ++m)
#pragma unroll
                    for (int bj = 0; bj < 2; ++bj) { const size_t off = (size_t)(row0 + ai * 128 + m * 16) * D + col0 + bj * 128;
                        f32x4 g0, g1; unpack8(*(const u32x4*)(ga + off), g0, g1);
                        *(u32x4*)(mrg + off) = pack8(g0 * acc[ai][bj][m][0], g1 * acc[ai][bj][m][1]);
                        asm volatile("" ::: "memory"); }
        }
    }
};
struct EpiSsmProj { const bf16_t* gs; bf16_t* mrg;
    __device__ __forceinline__ void operator()(const AccT& acc, const Unit& u, int wr, int wc, int fr, int fq) const {
        const int row0 = u.pm * 256 + wr * 64 + fr, col0 = u.pn * 256 + wc * 32 + 8 * fq;
#pragma unroll
        for (int ai = 0; ai < 2; ++ai)
#pragma unroll
            for (int m = 0; m < 4; ++m)
#pragma unroll
                for (int bj = 0; bj < 2; ++bj) { const size_t off = (size_t)(row0 + ai * 128 + m * 16) * D + col0 + bj * 128;
                    f32x4 g0, g1, p0, p1; unpack8(*(const u32x4*)(gs + off), g0, g1); unpack8(*(const u32x4*)(mrg + off), p0, p1);
                    *(u32x4*)(mrg + off) = pack8(p0 + g0 * acc[ai][bj][m][0], p1 + g1 * acc[ai][bj][m][1]);
                    asm volatile("" ::: "memory"); }
    }
};
struct EpiStoreBf16 { bf16_t* out;
    __device__ __forceinline__ void operator()(const AccT& acc, const Unit& u, int wr, int wc, int fr, int fq) const {
        const int row0 = u.pm * 256 + wr * 64 + fr, col0 = u.pn * 256 + wc * 32 + 8 * fq;
#pragma unroll
        for (int ai = 0; ai < 2; ++ai)
#pragma unroll
            for (int m = 0; m < 4; ++m)
#pragma unroll
                for (int bj = 0; bj < 2; ++bj) *(u32x4*)(out + (size_t)(row0 + ai * 128 + m * 16) * D + col0 + bj * 128) = pack8(acc[ai][bj][m][0], acc[ai][bj][m][1]);
    }
};
struct EpiPleGate { float* h; const bf16_t* proj; const u64* ss;
    __device__ __forceinline__ void operator()(const AccT& acc, const Unit& u, int wr, int wc, int fr, int fq) const {
        const int row0 = u.pm * 256 + wr * 64 + fr, col0 = u.pn * 256 + wc * 32 + 8 * fq;
#pragma unroll
        for (int ai = 0; ai < 2; ++ai)
#pragma unroll
            for (int m = 0; m < 4; ++m) { const int row = row0 + ai * 128 + m * 16; const float rr = rinv_of(ss[row]);
#pragma unroll
                for (int bj = 0; bj < 2; ++bj) { const size_t off = (size_t)row * D + col0 + bj * 128; f32x4 pj[2]; unpack8(*(const u32x4*)(proj + off), pj[0], pj[1]);
#pragma unroll
                    for (int n = 0; n < 2; ++n) { const f32x4 hv = *(const f32x4*)(h + off + 4 * n), pv = pj[n]; f32x4 o;
#pragma unroll
                        for (int e = 0; e < 4; ++e) o[e] = hv[e] + pv[e] * fsigmoid(acc[ai][bj][m][n][e] * rr);
                        *(f32x4*)(h + off + 4 * n) = o; }
                    asm volatile("" ::: "memory"); } }
    }
};

#define XB_TMO      128
#define XB_XCNT(j)  (256  + 64 * (j))
#define XB_XSUB(j)  (1280 + 64 * (j))
#define XB_XGEN(j)  (2304 + 64 * (j))
#define XB_TOP      3328
#define XB_TOPGEN   3392
#define XCD_BAR_WORDS 3456
#define XB_SPIN_CAP (1u << 18)
__device__ __forceinline__ unsigned xb_ld(unsigned* p)              { return __hip_atomic_load(p, __ATOMIC_RELAXED, __HIP_MEMORY_SCOPE_AGENT); }
__device__ __forceinline__ unsigned xb_add(unsigned* p, unsigned v) { return __hip_atomic_fetch_add(p, v, __ATOMIC_RELAXED, __HIP_MEMORY_SCOPE_AGENT); }
__device__ __forceinline__ unsigned xb_xcc_id() { return (unsigned)__builtin_amdgcn_s_getreg((3 << 11) | 20) & 0xFu; }
#define XB_SPIN(cond, bar) do { unsigned _sp = 0; while (cond) { __builtin_amdgcn_s_sleep(1); \
    if ((++_sp & 255u) == 0u) { if (xb_ld(&(bar)[XB_TMO])) break; if (_sp > XB_SPIN_CAP) { atomicAdd(&(bar)[XB_TMO], 1u); break; } } } } while (0)
struct XcdBarrier { unsigned* bar; unsigned x; volatile LAS unsigned* st; };
__device__ __forceinline__ XcdBarrier xcd_barrier_post(unsigned* bar, volatile LAS unsigned* st) {
    XcdBarrier b; b.bar = bar; b.x = xb_xcc_id(); b.st = st;
    if (threadIdx.x == 0) (void)xb_add(&bar[XB_XCNT(b.x)], 1u);
    return b;
}
__device__ __forceinline__ void xcd_barrier_complete(unsigned* bar, unsigned x, unsigned& nloc, unsigned& nx) {
    const unsigned G = gridDim.x * gridDim.y * gridDim.z;
    unsigned sum, cnt, mine, sp = 0u;
    for (;;) {
        sum = 0u; cnt = 0u; mine = 0u;
#pragma unroll
        for (unsigned j = 0; j < 16; ++j) { const unsigned c = xb_ld(&bar[XB_XCNT(j)]); sum += c; cnt += (c > 0u) ? 1u : 0u; mine = (j == x) ? c : mine; }
        if (sum == G) break;
        __builtin_amdgcn_s_sleep(1);
        if ((++sp & 255u) == 0u) { if (xb_ld(&bar[XB_TMO])) break; if (sp > XB_SPIN_CAP) { atomicAdd(&bar[XB_TMO], 1u); break; } }
    }
    nloc = mine > 0u ? mine : 1u; nx = cnt > 0u ? cnt : 1u;
}
__device__ __forceinline__ void xcd_barrier(const XcdBarrier& b) {
    asm volatile("s_waitcnt vmcnt(0)" ::: "memory");
    __syncthreads();
    if (threadIdx.x == 0) {
        unsigned* bar = b.bar;
        __builtin_amdgcn_s_waitcnt(0);
        unsigned nloc = b.st[0], nx = b.st[1];
        if (nloc == 0u) { xcd_barrier_complete(bar, b.x, nloc, nx); b.st[0] = nloc; b.st[1] = nx; }
        const unsigned old = xb_add(&bar[XB_XSUB(b.x)], 1u);
        const unsigned gen = old / nloc;
        if (old + 1u == (gen + 1u) * nloc) {
            __builtin_amdgcn_fence(__ATOMIC_RELEASE, "agent");
            asm volatile("s_waitcnt vmcnt(0)" ::: "memory");
            const unsigned og = xb_add(&bar[XB_TOP], 1u);
            const unsigned tg = og / nx;
            if (og + 1u == (tg + 1u) * nx) xb_add(&bar[XB_TOPGEN], 1u);
            else XB_SPIN(xb_ld(&bar[XB_TOPGEN]) == tg, bar);
            __builtin_amdgcn_fence(__ATOMIC_ACQUIRE, "agent");
            xb_add(&bar[XB_XGEN(b.x)], 1u);
            asm volatile("s_waitcnt vmcnt(0)" ::: "memory");
        } else {
            XB_SPIN(xb_ld(&bar[XB_XGEN(b.x)]) == gen, bar);
            __builtin_amdgcn_fence(__ATOMIC_ACQUIRE, "agent");
            asm volatile("s_waitcnt vmcnt(0)" ::: "memory");
        }
    }
    __syncthreads();
}

#define LDS_WAIT() asm volatile("s_waitcnt lgkmcnt(0)" ::: "memory")
__device__ __forceinline__ unsigned pk2(float lo, float hi) { return (unsigned)f2bf(lo) | ((unsigned)f2bf(hi) << 16); }
constexpr int P0_SCR_BYTES = 17408;
__device__ __forceinline__ void p0_transpose_item(const float* W, int K, int N, bf16_t* WT, int grp, int gstride, int goff, const float* gain, LAS float* scr, int item, int lane) {
    const int nblk = N / 64, kb = item / nblk, nb = item % nblk, k0 = 64 * kb, n0 = 64 * nb, kq = lane >> 4, nq = lane & 15;
    f32x4 v[16];
#pragma unroll
    for (int i = 0; i < 16; ++i) v[i] = *(const f32x4*)(W + (size_t)(k0 + 4 * i + kq) * N + n0 + 4 * nq);
#pragma unroll
    for (int i = 0; i < 16; ++i) { const float gsc = gain ? gain[k0 + 4 * i + kq] : 1.0f; LAS float* d = scr + (4 * i + kq) * 65 + 4 * nq; d[0] = v[i][0] * gsc; d[1] = v[i][1] * gsc; d[2] = v[i][2] * gsc; d[3] = v[i][3] * gsc; }
    LDS_WAIT(); asm volatile("" ::: "memory");
    const int c = lane & 7;
#pragma unroll
    for (int j = 0; j < 8; ++j) { const int n = (lane >> 3) + 8 * j; const LAS float* sp = scr + (8 * c) * 65 + n; const int nn = n0 + n, dr = (nn / grp) * gstride + goff + nn % grp;
        u32x4 o; o.x = cvt_pk_bf16(sp[0 * 65], sp[1 * 65]); o.y = cvt_pk_bf16(sp[2 * 65], sp[3 * 65]); o.z = cvt_pk_bf16(sp[4 * 65], sp[5 * 65]); o.w = cvt_pk_bf16(sp[6 * 65], sp[7 * 65]);
        *(u32x4*)(WT + (size_t)dr * K + k0 + 8 * c) = o; }
    LDS_WAIT(); asm volatile("" ::: "memory");
}
__device__ __forceinline__ float wave_sum(float v) {
#pragma unroll
    for (int o = 1; o < 64; o <<= 1) v += __shfl_xor(v, o);
    return v;
}
__device__ __forceinline__ void p0_ssm_group(LAS unsigned char* lds, int g, int dir, const float* lam_re, const float* lam_im, const float* log_dt, const float* b_re, const float* b_im,
                                              const float* c_re, const float* c_im, const float* dsk, bf16_t* Bt1, bf16_t* Bt2, f32x2* aT) {
    LAS f32x2* bb = (LAS f32x2*)lds; LAS f32x2* ap = (LAS f32x2*)(lds + 16384); LAS f32x2* cc = (LAS f32x2*)(lds + 33280); LAS float* kt = (LAS float*)(lds + 49664);
    const int tid = threadIdx.x;
    if (tid < 128) {
        const int own = (tid < 64), d = own ? dir : 1 - dir, p = tid & 63, gp = (d * NG + g) * NP + p, sl = own ? 0 : 1;
        const double lr = fmin((double)lam_re[gp], -1e-4), li = (double)lam_im[gp], dt = exp((double)log_dt[d * NG + g]);
        const double er = exp(lr * dt), ar = er * cos(li * dt), ai = er * sin(li * dt);
        const double nr = ar - 1.0, ni = ai, den = lr * lr + li * li;
        const double fr = (nr * lr + ni * li) / den, fi = (ni * lr - nr * li) / den;
        for (int i = 0; i < GC; ++i) { const double br = b_re[(size_t)gp * GC + i], bi = b_im[(size_t)gp * GC + i]; bb[(sl * 64 + p) * 16 + i] = (f32x2){(float)(fr * br - fi * bi), (float)(fr * bi + fi * br)}; }
        if (own) { double pr = 1.0, pi = 0.0;
            for (int k = 0; k <= TC; ++k) { ap[p * 33 + k] = (f32x2){(float)pr, (float)pi}; const double t = pr * ar - pi * ai; pi = pr * ai + pi * ar; pr = t; }
            aT[gp] = ap[p * 33 + TC]; }
    }
    for (int e = tid; e < 2 * 16 * 64; e += 512) { const int sl = e >> 10, o = (e >> 6) & 15, p = e & 63, d = sl ? 1 - dir : dir; const size_t ci = ((size_t)(d * NG + g) * GC + o) * NP + p; cc[(sl * 64 + p) * 16 + o] = (f32x2){c_re[ci], c_im[ci]}; }
    __syncthreads();
    for (int e = tid; e < 33 * 16 * 4; e += 512) { const int i4 = (e & 3) * 4, o = (e >> 2) & 15, k = e >> 6, sl = (k == 32) ? 1 : 0;
        float s0 = 0.f, s1 = 0.f, s2 = 0.f, s3 = 0.f;
        for (int p = 0; p < 64; ++p) { const f32x2 c = cc[(sl * 64 + p) * 16 + o]; float wr_ = c.x, wi_ = c.y;
            if (!sl) { const f32x2 a = ap[p * 33 + k]; wr_ = c.x * a.x - c.y * a.y; wi_ = c.x * a.y + c.y * a.x; }
            const LAS f32x2* b = bb + (sl * 64 + p) * 16 + i4;
            s0 += wr_ * b[0].x - wi_ * b[0].y; s1 += wr_ * b[1].x - wi_ * b[1].y; s2 += wr_ * b[2].x - wi_ * b[2].y; s3 += wr_ * b[3].x - wi_ * b[3].y; }
        LAS float* dd = kt + (k * 16 + o) * 16 + i4; dd[0] = s0; dd[1] = s1; dd[2] = s2; dd[3] = s3; }
    __syncthreads();
    bf16_t* B1 = Bt1 + (size_t)g * 768 * 512;
    for (int e = tid; e < 512 * 64; e += 512) { const int n = e >> 6, k8 = (e & 63) * 8, tau = n >> 4, o = n & 15, sg = k8 >> 4, i0 = k8 & 15;
        const bool mine = (dir == 0) ? (tau >= sg) : (tau < sg); if (!mine) continue;
        float v[8];
        if (tau != sg) { const int lag = tau > sg ? tau - sg : sg - tau; const LAS float* sp = kt + (lag * 16 + o) * 16 + i0;
#pragma unroll
            for (int j = 0; j < 8; ++j) v[j] = sp[j]; }
        else { const LAS float* s0 = kt + (0 * 16 + o) * 16 + i0; const LAS float* s1 = kt + (32 * 16 + o) * 16 + i0; const float dd = dsk[g * GC + o];
#pragma unroll
            for (int j = 0; j < 8; ++j) v[j] = s0[j] + s1[j] + ((i0 + j) == o ? dd : 0.f); }
        u32x4 w; w.x = pk2(v[0], v[1]); w.y = pk2(v[2], v[3]); w.z = pk2(v[4], v[5]); w.w = pk2(v[6], v[7]);
        *(u32x4*)(B1 + (size_t)n * 512 + k8) = w; }
    for (int e = tid; e < 128 * 64; e += 512) { const int r = e >> 6, k8 = (e & 63) * 8, im = r >> 6, p = r & 63, sg = k8 >> 4, i0 = k8 & 15;
        const f32x2 a = ap[p * 33 + (dir == 0 ? (TC - 1 - sg) : sg)]; float v[8];
#pragma unroll
        for (int j = 0; j < 8; ++j) { const f32x2 b = bb[p * 16 + i0 + j]; v[j] = im ? (a.x * b.y + a.y * b.x) : (a.x * b.x - a.y * b.y); }
        u32x4 w; w.x = pk2(v[0], v[1]); w.y = pk2(v[2], v[3]); w.z = pk2(v[4], v[5]); w.w = pk2(v[6], v[7]);
        *(u32x4*)(B1 + (size_t)(512 + 128 * dir + r) * 512 + k8) = w; }
    bf16_t* B2 = Bt2 + (size_t)g * 512 * 256;
    for (int e = tid; e < 512 * 16; e += 512) { const int n = e >> 4, k8 = (e & 15) * 8, tau = n >> 4, o = n & 15, im = k8 >> 6, p0 = k8 & 63; float v[8];
#pragma unroll
        for (int j = 0; j < 8; ++j) { const int p = p0 + j; const f32x2 c = cc[p * 16 + o], a = ap[p * 33 + (dir == 0 ? tau + 1 : TC - tau)];
            v[j] = im ? -(c.x * a.y + c.y * a.x) : (c.x * a.x - c.y * a.y); }
        u32x4 w; w.x = pk2(v[0], v[1]); w.y = pk2(v[2], v[3]); w.z = pk2(v[4], v[5]); w.w = pk2(v[6], v[7]);
        *(u32x4*)(B2 + (size_t)n * 256 + 128 * dir + k8) = w; }
    __syncthreads();
}

typedef short s16x4 __attribute__((ext_vector_type(4)));
__device__ __forceinline__ s16x4 tr_read(const LAS unsigned char* p) { return __builtin_bit_cast(s16x4, __builtin_amdgcn_ds_read_tr16_b64_v4i16((LAS s16x4*)p)); }
constexpr int ATT_V_BYTES = 9 * 64 * 128, ATT_RPB_OFF = ATT_V_BYTES;
__device__ __forceinline__ void attn_phase(LAS unsigned char* lds, const bf16_t* __restrict__ Q, const bf16_t* __restrict__ Kg, const bf16_t* __restrict__ Vg, const float* __restrict__ rpb, bf16_t* __restrict__ AO, int G, int bx) {
    const int tid = threadIdx.x, lane = tid & 63, w = __builtin_amdgcn_readfirstlane(tid >> 6), g4 = lane >> 4, l15 = lane & 15;
    LAS float* rp = (LAS float*)(lds + ATT_RPB_OFF);
    constexpr int NUNITS = BATCH * NHEAD * (ROWS / 2);
    for (int un = bx; un < NUNITS; un += G) {
        const int per = (NUNITS + G - 1) / G; const int u2 = (un % G) * per + un / G; if (u2 >= NUNITS) continue;
        const int bh = u2 / (ROWS / 2), rpair = u2 % (ROWS / 2), b = bh >> 3, h = bh & 7, r0 = 2 * rpair;
        int rsu = r0 - 4; rsu = rsu < 0 ? 0 : (rsu > ROWS - 8 ? ROWS - 8 : rsu);
        __syncthreads();
        { const int t = tid >> 3, c = tid & 7;
#pragma unroll
          for (int j = 0; j < 9; ++j) { const int row = rsu + j; if (row < ROWS) { const u32x4 v = *(const u32x4*)(Vg + ((size_t)b * SEQ + row * GW + t) * AW + h * HD + c * 8);
              *(LAS u32x4*)(lds + (j * 64 + t) * 128 + ((c ^ (t & 7)) << 4)) = v; } }
          if (tid < 465) rp[tid] = rpb[h * 465 + tid]; }
        const int r = r0 + (w >> 2), c0 = (w & 3) * 16;
        int rs = r - 4; rs = rs < 0 ? 0 : (rs > ROWS - 8 ? ROWS - 8 : rs);
        int wst = c0 - 8; wst = wst < 0 ? 0 : (wst > 32 ? 32 : wst);
        const size_t tq = (size_t)b * SEQ + r * GW + c0 + l15;
        bf16x8 qf[2];
#pragma unroll
        for (int kk = 0; kk < 2; ++kk) qf[kk] = *(const bf16x8*)(Q + tq * AW + h * HD + 8 * g4 + 32 * kk);
        f32x4 sacc[8][2];
        const bf16_t* kbase = Kg + ((size_t)b * SEQ + rs * GW + wst + l15) * AW + h * HD + 8 * g4;
#pragma unroll
        for (int kr = 0; kr < 8; ++kr)
#pragma unroll
            for (int nb = 0; nb < 2; ++nb) { f32x4 a = {0.f, 0.f, 0.f, 0.f};
#pragma unroll
                for (int kk = 0; kk < 2; ++kk) { const bf16x8 kf = *(const bf16x8*)(kbase + (size_t)(kr * GW + nb * 16) * AW + 32 * kk); a = __builtin_amdgcn_mfma_f32_16x16x32_bf16(kf, qf[kk], a, 0, 0, 0); }
                sacc[kr][nb] = a; }
        __syncthreads();
        const int c = c0 + l15; int cs = c - 8; cs = cs < 0 ? 0 : (cs > GW - 16 ? GW - 16 : cs);
        float mx = -1e30f;
#pragma unroll
        for (int kr = 0; kr < 8; ++kr) { const LAS float* brow = rp + (rs + kr - r + 7) * 31;
#pragma unroll
            for (int nb = 0; nb < 2; ++nb)
#pragma unroll
                for (int e = 0; e < 4; ++e) { const int kc = wst + 16 * nb + 4 * g4 + e; const bool ok = (kc >= cs) && (kc < cs + 16); const int dc = ok ? (kc - c + 15) : 0;
                    const float sv = ok ? sacc[kr][nb][e] + brow[dc] : -1e30f; sacc[kr][nb][e] = sv; mx = fmaxf(mx, sv); } }
        mx = fmaxf(mx, __shfl_xor(mx, 16)); mx = fmaxf(mx, __shfl_xor(mx, 32));
        float sum = 0.f; bf16x8 pb[8];
#pragma unroll
        for (int kr = 0; kr < 8; ++kr) { float pv[8];
#pragma unroll
            for (int nb = 0; nb < 2; ++nb)
#pragma unroll
                for (int e = 0; e < 4; ++e) { const float p = __builtin_amdgcn_exp2f((sacc[kr][nb][e] - mx) * 1.4426950408889634f); pv[nb * 4 + e] = p; sum += p; }
            u32x4 wv; wv.x = cvt_pk_bf16(pv[0], pv[1]); wv.y = cvt_pk_bf16(pv[2], pv[3]); wv.z = cvt_pk_bf16(pv[4], pv[5]); wv.w = cvt_pk_bf16(pv[6], pv[7]);
            pb[kr] = __builtin_bit_cast(bf16x8, wv); }
        sum += __shfl_xor(sum, 16); sum += __shfl_xor(sum, 32);
        f32x4 oacc[4];
#pragma unroll
        for (int d = 0; d < 4; ++d) oacc[d] = (f32x4){0.f, 0.f, 0.f, 0.f};
        const int q4 = (lane >> 2) & 3, p4 = lane & 3;
#pragma unroll
        for (int kr = 0; kr < 8; ++kr) { const int slot = rs + kr - rsu;
            const int t0 = wst + 4 * g4 + q4, t1 = t0 + 16;
            const LAS unsigned char* row0 = lds + (slot * 64 + t0) * 128 + (p4 & 1) * 8; const LAS unsigned char* row1 = lds + (slot * 64 + t1) * 128 + (p4 & 1) * 8;
#pragma unroll
            for (int d = 0; d < 4; ++d) { const int ch = 2 * d + (p4 >> 1);
                const s16x4 v0 = tr_read(row0 + ((ch ^ (t0 & 7)) << 4)), v1 = tr_read(row1 + ((ch ^ (t1 & 7)) << 4));
                bf16x8 vf; vf[0] = v0[0]; vf[1] = v0[1]; vf[2] = v0[2]; vf[3] = v0[3]; vf[4] = v1[0]; vf[5] = v1[1]; vf[6] = v1[2]; vf[7] = v1[3];
                oacc[d] = __builtin_amdgcn_mfma_f32_16x16x32_bf16(vf, pb[kr], oacc[d], 0, 0, 0); } }
        const float inv = 1.0f / sum;
#pragma unroll
        for (int d = 0; d < 4; ++d) { const f32x4 o = oacc[d] * inv; *(u32x2*)(AO + tq * AW + h * HD + 16 * d + 4 * g4) = (u32x2){cvt_pk_bf16(o[0], o[1]), cvt_pk_bf16(o[2], o[3])}; }
    }
    __syncthreads();
}

struct Args { const float* in[30]; float* out; unsigned char* ws; int ph_lo, ph_hi; };
constexpr int N_PHASES = 14;

__global__ void __launch_bounds__(512, 2) mk_fwd(Args args) {
    extern __shared__ __attribute__((aligned(16))) unsigned char lds_raw[];
    LAS unsigned char* lds = (LAS unsigned char*)lds_raw;
    volatile LAS unsigned* MISC = (volatile LAS unsigned*)(lds + MISC_OFF);
    const int tid = threadIdx.x, lane = tid & 63, wave = __builtin_amdgcn_readfirstlane(tid >> 6);
    const int G = gridDim.x, bx = blockIdx.x;
    unsigned char* ws = args.ws;
    unsigned* ctl = (unsigned*)(ws + WS_CTL);
    u64* ss0 = (u64*)(ws + WS_SS); u64* ss1 = ss0 + M; u64* ss2 = ss1 + M; u64* ss3 = ss2 + M;
    float* hout = args.out;
    bf16_t* HB = (bf16_t*)(ws + WS_HB);
    const int lo = args.ph_lo, hi = args.ph_hi;
#define IN(k) (((PH_MASK >> (k)) & 1) && lo <= (k) && (k) < hi)
#define BOTH(k) (IN(k) && IN((k) + 1))
    for (int u = tid; u < 64; u += 512) MISC[u] = 0u;
    __syncthreads();
    XcdBarrier bar; bar.bar = ctl + CW_BAR; bar.x = 0; bar.st = nullptr;
    if (hi - lo > 1) bar = xcd_barrier_post(ctl + CW_BAR, MISC + 8);
#define GRID_BAR() xcd_barrier(bar)
#ifdef TS_SEL
    unsigned long long* tsw = (unsigned long long*)(ctl + 2048);
#define STAMP(k) do { if (bx == 0 && tid == 0) tsw[(k)] = __builtin_amdgcn_s_memrealtime(); } while (0)
#else
#define STAMP(k) do {} while (0)
#endif
    STAMP(0);
    const int gw = bx * 8 + wave, NGW = G * 8;

    if (IN(0)) {
        const float* x = args.in[0];
        const int nssm = (G > 128) ? 2 * NG : 0;
        if (G > 128) { if (bx < 2 * NG) p0_ssm_group(lds, bx >> 1, bx & 1, args.in[9], args.in[10], args.in[11], args.in[12], args.in[13], args.in[14], args.in[15], args.in[16], (bf16_t*)(ws + WS_BT1), (bf16_t*)(ws + WS_BT2), (f32x2*)(ws + WS_AT)); }
        else { for (int u = bx; u < 2 * NG; u += G) p0_ssm_group(lds, u >> 1, u & 1, args.in[9], args.in[10], args.in[11], args.in[12], args.in[13], args.in[14], args.in[15], args.in[16], (bf16_t*)(ws + WS_BT1), (bf16_t*)(ws + WS_BT2), (f32x2*)(ws + WS_AT)); }
        if (bx >= nssm) {
            LAS float* scr = (LAS float*)(lds + wave * P0_SCR_BYTES);
            const int w0 = (bx - nssm) * 8 + wave, NW = (G - nssm) * 8;
            constexpr int I_GU = (D / 64) * (FF / 64), I_DN = (FF / 64) * (D / 64), I_IN = (D / 64) * (NIN / 64), I_GLU = (SW / 64) * (SW / 64), I_O = (AW / 64) * (D / 64), I_DD = (D / 64) * (D / 64), I_PP = (PLE / 64) * (D / 64);
            constexpr int NITEMS = 4 * I_GU + 2 * I_DN + I_IN + I_GLU + 2 * I_O + 2 * I_DD + I_PP;
            for (int it = w0; it < NITEMS; it += NW) {
                int r = it;
                if (r < I_GU) { p0_transpose_item(args.in[3], D, FF, (bf16_t*)(ws + WS_WGU1), 128, 256, 0, args.in[2], scr, r, lane); continue; } r -= I_GU;
                if (r < I_GU) { p0_transpose_item(args.in[4], D, FF, (bf16_t*)(ws + WS_WGU1), 128, 256, 128, args.in[2], scr, r, lane); continue; } r -= I_GU;
                if (r < I_DN) { p0_transpose_item(args.in[5], FF, D, (bf16_t*)(ws + WS_WD1), D, 0, 0, nullptr, scr, r, lane); continue; } r -= I_DN;
                if (r < I_IN) { p0_transpose_item(args.in[7], D, NIN, (bf16_t*)(ws + WS_WIN), NIN, 0, 0, args.in[6], scr, r, lane); continue; } r -= I_IN;
                if (r < I_GLU) { p0_transpose_item(args.in[17], SW, SW, (bf16_t*)(ws + WS_WGLU), SW, 0, 0, nullptr, scr, r, lane); continue; } r -= I_GLU;
                if (r < I_O) { p0_transpose_item(args.in[19], AW, D, (bf16_t*)(ws + WS_WOS), D, 0, 0, nullptr, scr, r, lane); continue; } r -= I_O;
                if (r < I_O) { p0_transpose_item(args.in[20], SW, D, (bf16_t*)(ws + WS_WOS), D, 0, D, nullptr, scr, r, lane); continue; } r -= I_O;
                if (r < I_DD) { p0_transpose_item(args.in[21], D, D, (bf16_t*)(ws + WS_WOUT), D, 0, 0, nullptr, scr, r, lane); continue; } r -= I_DD;
                if (r < I_GU) { p0_transpose_item(args.in[23], D, FF, (bf16_t*)(ws + WS_WGU2), 128, 256, 0, args.in[22], scr, r, lane); continue; } r -= I_GU;
                if (r < I_GU) { p0_transpose_item(args.in[24], D, FF, (bf16_t*)(ws + WS_WGU2), 128, 256, 128, args.in[22], scr, r, lane); continue; } r -= I_GU;
                if (r < I_DN) { p0_transpose_item(args.in[25], FF, D, (bf16_t*)(ws + WS_WD2), D, 0, 0, nullptr, scr, r, lane); continue; } r -= I_DN;
                if (r < I_DD) { p0_transpose_item(args.in[27], D, D, (bf16_t*)(ws + WS_WPG), D, 0, 0, args.in[26], scr, r, lane); continue; } r -= I_DD;
                p0_transpose_item(args.in[28], PLE, D, (bf16_t*)(ws + WS_WPP), D, 0, 0, nullptr, scr, r, lane);
            }
            { const float* pin = args.in[1]; bf16_t* PB = (bf16_t*)(ws + WS_PB);
              for (size_t i = (size_t)w0 * 256 + lane; i < (size_t)M * PLE / 8; i += (size_t)NW * 256) { f32x4 a[4], b[4];
#pragma unroll
                  for (int q = 0; q < 4; ++q) { a[q] = *(const f32x4*)(pin + (i + 64 * q) * 8); b[q] = *(const f32x4*)(pin + (i + 64 * q) * 8 + 4); }
#pragma unroll
                  for (int q = 0; q < 4; ++q) *(u32x4*)(PB + (i + 64 * q) * 8) = pack8(a[q], b[q]); } }
            for (int m = 2 * w0; m < M; m += 2 * NW) {
                const f32x4* xr = (const f32x4*)(x + (size_t)m * D) + lane; f32x4 v[8]; float s0 = 0.f, s1 = 0.f;
#pragma unroll
                for (int j = 0; j < 8; ++j) v[j] = xr[64 * j];
#pragma unroll
                for (int j = 0; j < 4; ++j) { s0 += (v[j][0] * v[j][0] + v[j][1] * v[j][1]) + (v[j][2] * v[j][2] + v[j][3] * v[j][3]); s1 += (v[4 + j][0] * v[4 + j][0] + v[4 + j][1] * v[4 + j][1]) + (v[4 + j][2] * v[4 + j][2] + v[4 + j][3] * v[4 + j][3]); }
                s0 = wave_sum(s0); s1 = wave_sum(s1); if (lane == 0) { ss0[m] = ss_fix(s0); ss0[m + 1] = ss_fix(s1); }
                u32x2* o8 = (u32x2*)(HB + (size_t)m * D) + lane;
#pragma unroll
                for (int j = 0; j < 8; ++j) o8[64 * j] = (u32x2){cvt_pk_bf16(v[j][0], v[j][1]), cvt_pk_bf16(v[j][2], v[j][3])};
            }
        }
        if (BOTH(0)) GRID_BAR();
        STAMP(1);
    }
    if (IN(1)) {
        pg8::Gemm g{(const char*)HB, (const char*)(ws + WS_WGU1), D, D, D, 128, 0}; pg8::PlainOrder S{M / 256, 2 * FF / 256, G, bx, D, D};
        EpiSwiglu E{(bf16_t*)(ws + WS_ACT), ss0};
        pg8::gemm_phase<EpiSwiglu, pg8::PlainOrder, true>(lds, g, S, E);
        if (BOTH(1)) GRID_BAR();
        STAMP(2);
    }
    if (IN(2)) {
        pg8::Gemm g{(const char*)(ws + WS_ACT), (const char*)(ws + WS_WD1), FF, FF, FF, 128, 0}; pg8::PlainOrder S{M / 256, D / 256, G, bx, FF, FF};
        EpiResid E{args.in[0], hout, HB, ss1, 0.5f};
        pg8::gemm_phase<EpiResid, pg8::PlainOrder, true>(lds, g, S, E);
        if (BOTH(2)) GRID_BAR();
        STAMP(3);
    }
    if (IN(3)) {
        pg8::Gemm g{(const char*)HB, (const char*)(ws + WS_WIN), D, D, D, 128, 0}; pg8::PlainOrder S{M / 256, NIN / 256, G, bx, D, D};
        EpiWin E{(bf16_t*)(ws + WS_Q), (bf16_t*)(ws + WS_GA), ss1};
        pg8::gemm_phase<EpiWin, pg8::PlainOrder, true>(lds, g, S, E);
        if (BOTH(3)) GRID_BAR();
        STAMP(4);
    }
    if (IN(4)) {
        attn_phase(lds, (const bf16_t*)(ws + WS_Q), (const bf16_t*)(ws + WS_K), (const bf16_t*)(ws + WS_V), args.in[8], (bf16_t*)(ws + WS_AO), G, bx);
        pg8::Gemm g{(const char*)(ws + WS_U), (const char*)(ws + WS_BT1), 512, (unsigned)(TC * SW), 512, (unsigned)(4 * SW * 2), 1};
        pg8::SsmOrder S{3, G, bx, (size_t)GC * 2, (size_t)SEQ * SW * 2, (size_t)768 * 512 * 2, (size_t)256 * 512 * 2};
        EpiSsm1 E{(bf16_t*)(ws + WS_YI), (float*)(ws + WS_E)};
        pg8::gemm_phase<EpiSsm1, pg8::SsmOrder, true>(lds, g, S, E);
        if (BOTH(4)) GRID_BAR();
        STAMP(5);
    }
    if (IN(5)) {
        const float* E = (const float*)(ws + WS_E); bf16_t* XC = (bf16_t*)(ws + WS_XC); const f32x2* aTt = (const f32x2*)(ws + WS_AT);
        LAS f32x2* endst = (LAS f32x2*)lds;
        for (int un = bx; un < NG * BATCH; un += G) {
            const int g = un >> 2, b = un & 3, rec = tid & 127, dir = rec >> 6, p = rec & 63, seg = tid >> 7;
            const f32x2 a = aTt[(dir * NG + g) * NP + p];
            const size_t rb = ((size_t)(g * BATCH + b) * NC) * 256 + dir * 128 + p;
            float xr = 0.f, xi = 0.f;
#pragma unroll 8
            for (int j = 0; j < 64; ++j) { const int c = dir == 0 ? seg * 64 + j : seg * 64 + 63 - j; const float er = E[rb + (size_t)c * 256], ei = E[rb + (size_t)c * 256 + 64];
                const float t = a.x * xr - a.y * xi + er; xi = a.x * xi + a.y * xr + ei; xr = t; }
            endst[seg * 128 + rec] = (f32x2){xr, xi};
            __syncthreads();
            float a64r = a.x, a64i = a.y;
#pragma unroll
            for (int s = 0; s < 6; ++s) { const float t = a64r * a64r - a64i * a64i; a64i = 2.f * a64r * a64i; a64r = t; }
            xr = 0.f; xi = 0.f;
            if (dir == 0) { for (int s = 0; s < seg; ++s) { const f32x2 e = endst[s * 128 + rec]; const float t = a64r * xr - a64i * xi + e.x; xi = a64r * xi + a64i * xr + e.y; xr = t; } }
            else { for (int s = 3; s > seg; --s) { const f32x2 e = endst[s * 128 + rec]; const float t = a64r * xr - a64i * xi + e.x; xi = a64r * xi + a64i * xr + e.y; xr = t; } }
#pragma unroll 8
            for (int j = 0; j < 64; ++j) { const int c = dir == 0 ? seg * 64 + j : seg * 64 + 63 - j; const float er = E[rb + (size_t)c * 256], ei = E[rb + (size_t)c * 256 + 64];
                XC[rb + (size_t)c * 256] = f2bf(xr); XC[rb + (size_t)c * 256 + 64] = f2bf(xi);
                const float t = a.x * xr - a.y * xi + er; xi = a.x * xi + a.y * xr + ei; xr = t; }
            __syncthreads();
        }
        if (BOTH(5)) GRID_BAR();
        STAMP(6);
    }
    if (IN(6)) {
        pg8::Gemm g{(const char*)(ws + WS_XC), (const char*)(ws + WS_BT2), 256, 256, 256, 128, 0};
        pg8::SsmOrder S{2, G, bx, (size_t)BATCH * NC * 256 * 2, (size_t)NC * 256 * 2, (size_t)512 * 256 * 2, (size_t)256 * 256 * 2};
        EpiSsm2 E{(const bf16_t*)(ws + WS_YI), (bf16_t*)(ws + WS_Y)};
        pg8::gemm_phase<EpiSsm2, pg8::SsmOrder, true>(lds, g, S, E);
        if (BOTH(6)) GRID_BAR();
        STAMP(7);
    }
    if (IN(7)) {
        pg8::Gemm g{(const char*)ws, (const char*)ws, 512, 512, 512, 128, 0}; pg8::MixOrder S{G, bx, WS_Y, WS_WGLU, WS_AO, WS_WOS};
        EpiMix E{(const bf16_t*)(ws + WS_Y), (bf16_t*)(ws + WS_YG), args.in[18], (const bf16_t*)(ws + WS_GA), (bf16_t*)(ws + WS_MRG)};
        pg8::gemm_phase<EpiMix, pg8::MixOrder, true>(lds, g, S, E);
        if (BOTH(7)) GRID_BAR();
        STAMP(8);
    }
    if (IN(8)) {
        pg8::Gemm g{(const char*)(ws + WS_YG), (const char*)(ws + WS_WOS + (size_t)D * 512 * 2), 512, 512, 512, 128, 0}; pg8::PlainOrder S{M / 256, D / 256, G, bx, 512, 512};
        EpiSsmProj E{(const bf16_t*)(ws + WS_GS), (bf16_t*)(ws + WS_MRG)};
        pg8::gemm_phase<EpiSsmProj, pg8::PlainOrder, true>(lds, g, S, E);
        if (BOTH(8)) GRID_BAR();
        STAMP(9);
    }
    if (IN(9)) {
        { pg8::Gemm g{(const char*)(ws + WS_PB), (const char*)(ws + WS_WPP), PLE, PLE, PLE, 128, 0}; pg8::PlainOrder S{M / 256, D / 256, G, bx, PLE, PLE};
          EpiStoreBf16 E{(bf16_t*)(ws + WS_PROJ)};
          pg8::gemm_phase<EpiStoreBf16, pg8::PlainOrder, true>(lds, g, S, E); }
        pg8::Gemm g{(const char*)(ws + WS_MRG), (const char*)(ws + WS_WOUT), D, D, D, 128, 0}; pg8::PlainOrder S{M / 256, D / 256, G, bx, D, D};
        EpiResid E{hout, hout, HB, ss2, 1.0f};
        pg8::gemm_phase<EpiResid, pg8::PlainOrder, true>(lds, g, S, E);
        if (BOTH(9)) GRID_BAR();
        STAMP(10);
    }
    if (IN(10)) {
        pg8::Gemm g{(const char*)HB, (const char*)(ws + WS_WGU2), D, D, D, 128, 0}; pg8::PlainOrder S{M / 256, 2 * FF / 256, G, bx, D, D};
        EpiSwiglu E{(bf16_t*)(ws + WS_ACT), ss2};
        pg8::gemm_phase<EpiSwiglu, pg8::PlainOrder, true>(lds, g, S, E);
        if (BOTH(10)) GRID_BAR();
        STAMP(11);
    }
    if (IN(11)) {
        { pg8::Gemm g{(const char*)(ws + WS_ACT), (const char*)(ws + WS_WD2), FF, FF, FF, 128, 0}; pg8::PlainOrder S{M / 256, D / 256, G, bx, FF, FF};
          EpiResid E{hout, hout, HB, ss3, 0.5f};
          pg8::gemm_phase<EpiResid, pg8::PlainOrder, true>(lds, g, S, E); }
        if (BOTH(11)) GRID_BAR();
        STAMP(12);
    }
    if (IN(12)) {
        pg8::Gemm g{(const char*)HB, (const char*)(ws + WS_WPG), D, D, D, 128, 0}; pg8::PlainOrder S{M / 256, D / 256, G, bx, D, D};
        EpiPleGate E{hout, (const bf16_t*)(ws + WS_PROJ), ss3};
        pg8::gemm_phase<EpiPleGate, pg8::PlainOrder, true>(lds, g, S, E);
        if (BOTH(12)) GRID_BAR();
        STAMP(13);
    }
    if (IN(13)) {
        const float* gn = args.in[29];
#ifdef TS_SEL
        bool ts_done = false;
#endif
        for (int m = gw; m < M; m += NGW) {
            f32x4* xr = (f32x4*)(hout + (size_t)m * D) + lane; f32x4 v[4]; float s = 0.f;
#pragma unroll
            for (int j = 0; j < 4; ++j) { v[j] = xr[64 * j]; s += (v[j][0] * v[j][0] + v[j][1] * v[j][1]) + (v[j][2] * v[j][2] + v[j][3] * v[j][3]); }
            const float r = rinv_f(wave_sum(s));
#pragma unroll
            for (int j = 0; j < 4; ++j) { const f32x4 gg = ((const f32x4*)gn)[lane + 64 * j]; v[j] = v[j] * r * gg; }
#ifdef TS_SEL
            if (gw == 0 && !ts_done) {
                const float dus = (float)(tsw[TS_SEL + 1] - tsw[TS_SEL]) * 0.01f; const float enc = 0.040f + 0.059f * fminf(dus, (float)TS_RANGE) / (float)TS_RANGE;
                int hit = -1;
#pragma unroll
                for (int j = 0; j < 4; ++j)
#pragma unroll
                    for (int e = 0; e < 4; ++e) if (hit < 0 && fabsf(v[j][e]) < 1e-3f) hit = j * 4 + e;
                const unsigned long long bal = __ballot(hit >= 0);
                if (bal) { const int first = __ffsll((long long)bal) - 1; if (lane == first) {
#pragma unroll
                    for (int j = 0; j < 4; ++j)
#pragma unroll
                        for (int e = 0; e < 4; ++e) if (hit == j * 4 + e) v[j][e] = enc; }
                    ts_done = true; }
            }
#endif
#pragma unroll
            for (int j = 0; j < 4; ++j) xr[64 * j] = v[j];
        }
    }
#undef IN
#undef BOTH
}

#if MK_SCAFFOLD && MK_MODE == 0
__global__ void __launch_bounds__(64) sc_natten(const bf16_t* __restrict__ q, const bf16_t* __restrict__ k, const bf16_t* __restrict__ v, const float* __restrict__ rpb, bf16_t* __restrict__ out) {
    const int idx = blockIdx.x * 64 + threadIdx.x; const int tok = idx >> 3, h = idx & 7, b = tok / SEQ, s = tok % SEQ, r = s / GW, c = s % GW;
    int rs = r - 4; rs = rs < 0 ? 0 : (rs > ROWS - 8 ? ROWS - 8 : rs);
    int cs = c - 8; cs = cs < 0 ? 0 : (cs > GW - 16 ? GW - 16 : cs);
    float qv[HD];
#pragma unroll
    for (int e = 0; e < HD; ++e) qv[e] = bf2f(q[(size_t)tok * AW + h * HD + e]);
    float mx = -1e30f;
    for (int j = 0; j < 8; ++j) for (int w = 0; w < 16; ++w) { const size_t kt = (size_t)b * SEQ + (rs + j) * GW + cs + w; const bf16_t* kp = k + kt * AW + h * HD;
        float d = 0.f;
#pragma unroll
        for (int e = 0; e < HD; ++e) d = fmaf(qv[e], bf2f(kp[e]), d);
        mx = fmaxf(mx, d + rpb[(h * 15 + (rs + j - r + 7)) * 31 + (cs + w - c + 15)]); }
    float o[HD];
#pragma unroll
    for (int e = 0; e < HD; ++e) o[e] = 0.f;
    float sum = 0.f;
    for (int j = 0; j < 8; ++j) for (int w = 0; w < 16; ++w) { const size_t kt = (size_t)b * SEQ + (rs + j) * GW + cs + w; const bf16_t* kp = k + kt * AW + h * HD; const bf16_t* vp = v + kt * AW + h * HD;
        float d = 0.f;
#pragma unroll
        for (int e = 0; e < HD; ++e) d = fmaf(qv[e], bf2f(kp[e]), d);
        const float pe = expf(d + rpb[(h * 15 + (rs + j - r + 7)) * 31 + (cs + w - c + 15)] - mx); sum += pe;
#pragma unroll
        for (int e = 0; e < HD; ++e) o[e] = fmaf(pe, bf2f(vp[e]), o[e]); }
    const float inv = 1.0f / sum;
#pragma unroll
    for (int e = 0; e < HD; ++e) out[(size_t)tok * AW + h * HD + e] = f2bf(o[e] * inv);
}
__global__ void __launch_bounds__(64) sc_s5(const bf16_t* __restrict__ ub, const float* __restrict__ lam_re, const float* __restrict__ lam_im, const float* __restrict__ log_dt,
                                            const float* __restrict__ b_re, const float* __restrict__ b_im, const float* __restrict__ c_re, const float* __restrict__ c_im, float* __restrict__ yf, int dir) {
    __shared__ float xr[64][65], xi[64][65], cr[16][64], ci[16][64], us[64][16];
    const int g = blockIdx.x, b = blockIdx.y, p = threadIdx.x; const int gp = (dir * NG + g) * NP + p;
    const double lr = fmin((double)lam_re[gp], -1e-4), li = (double)lam_im[gp], dt = exp((double)log_dt[dir * NG + g]);
    const double er = exp(lr * dt), ar = er * cos(li * dt), ai = er * sin(li * dt);
    const double nr = ar - 1.0, ni = ai, den = lr * lr + li * li; const double fr = (nr * lr + ni * li) / den, fi = (ni * lr - nr * li) / den;
    float bbr[16], bbi[16];
#pragma unroll
    for (int i = 0; i < 16; ++i) { const double br = b_re[(size_t)gp * GC + i], bi = b_im[(size_t)gp * GC + i]; bbr[i] = (float)(fr * br - fi * bi); bbi[i] = (float)(fr * bi + fi * br); }
    for (int o = 0; o < 16; ++o) { cr[o][p] = c_re[((size_t)(dir * NG + g) * GC + o) * NP + p]; ci[o][p] = c_im[((size_t)(dir * NG + g) * GC + o) * NP + p]; }
    const float far = (float)ar, fai = (float)ai; float sr = 0.f, si = 0.f;
    for (int blk = 0; blk < SEQ / 64; ++blk) {
        __syncthreads();
        for (int e = p; e < 64 * 16; e += 64) { const int tt = e >> 4, i = e & 15; const int t = dir ? (SEQ - 1 - (blk * 64 + tt)) : (blk * 64 + tt); us[tt][i] = bf2f(ub[((size_t)b * SEQ + t) * SW + g * GC + i]); }
        __syncthreads();
        for (int tt = 0; tt < 64; ++tt) { float br = 0.f, bi = 0.f;
#pragma unroll
            for (int i = 0; i < 16; ++i) { const float u = us[tt][i]; br = fmaf(bbr[i], u, br); bi = fmaf(bbi[i], u, bi); }
            const float n1 = far * sr - fai * si + br, n2 = far * si + fai * sr + bi; sr = n1; si = n2; xr[tt][p] = sr; xi[tt][p] = si; }
        __syncthreads();
        for (int e = p; e < 64 * 16; e += 64) { const int tt = e >> 4, o = e & 15; float a = 0.f;
            for (int q = 0; q < 64; ++q) a += xr[tt][q] * cr[o][q] - xi[tt][q] * ci[o][q];
            const int t = dir ? (SEQ - 1 - (blk * 64 + tt)) : (blk * 64 + tt); float* d = yf + ((size_t)b * SEQ + t) * SW + g * GC + o; if (dir) *d += a; else *d = a; }
    }
}
__global__ void sc_comb(const bf16_t* __restrict__ ub, const float* __restrict__ dsk, const float* __restrict__ yf, bf16_t* __restrict__ y) {
    size_t i = (size_t)blockIdx.x * blockDim.x + threadIdx.x; const int c = (int)(i % SW);
    y[i] = f2bf(gelu_tanh_f(dsk[c] * bf2f(ub[i]) + yf[i]));
}
#endif

#ifdef MK_TRUNC
__global__ void dump_k(const unsigned short* __restrict__ src, float* __restrict__ out, size_t n) {
    size_t i = (size_t)blockIdx.x * blockDim.x + threadIdx.x; if (i < n) out[i] = (float)src[i];
}
#endif
extern "C" void kernel_launch(void* const* d_in, const int* in_sizes, int n_in, void* d_out, int out_size, void* d_ws, size_t ws_size, hipStream_t stream) {
    static int grid = 0;
    if (grid == 0) {
        if (n_in != 30 || out_size != M * D || ws_size < WS_END) { fprintf(stderr, "kernel_launch: unexpected shapes (n_in %d out %d ws %zu)\n", n_in, out_size, ws_size); grid = -1; return; }
        int dev = 0, cus = 0;
        if (hipGetDevice(&dev) != hipSuccess || hipDeviceGetAttribute(&cus, hipDeviceAttributeMultiprocessorCount, dev) != hipSuccess) { grid = -1; return; }
        if (hipFuncSetAttribute((const void*)mk_fwd, hipFuncAttributeMaxDynamicSharedMemorySize, LDS_BYTES) != hipSuccess) { fprintf(stderr, "kernel_launch: hipFuncSetAttribute failed\n"); grid = -1; return; }
        (void)hipGetLastError();
        grid = cus;
    }
    if (grid < 0) return;
    (void)hipMemsetAsync((char*)d_ws + WS_CTL, 0, CTL_ZERO_BYTES, stream);
    Args a{};
    for (int i = 0; i < 30; ++i) a.in[i] = (const float*)d_in[i];
    a.out = (float*)d_out; a.ws = (unsigned char*)d_ws;
#if MK_MODE == 1
    a.ph_lo = 0; a.ph_hi = N_PHASES;
#ifdef MK_TRUNC
    a.ph_hi = MK_TRUNC + 1;
#endif
    hipLaunchKernelGGL(mk_fwd, dim3(grid), dim3(512), LDS_BYTES, stream, a);
#ifdef MK_TRUNC
    hipLaunchKernelGGL(dump_k, dim3((unsigned)((size_t)M * D / 256)), dim3(256), 0, stream, (const unsigned short*)((unsigned char*)d_ws + (size_t)MK_DUMP_MIB * MiB), (float*)d_out, (size_t)M * D);
#endif
#else
    unsigned char* ws = (unsigned char*)d_ws;
    for (int ph = 0; ph < N_PHASES; ++ph) {
#ifdef MK_TRUNC
        if (ph > MK_TRUNC) { hipLaunchKernelGGL(dump_k, dim3((unsigned)((size_t)M * D / 256)), dim3(256), 0, stream, (const unsigned short*)(ws + (size_t)MK_DUMP_MIB * MiB), (float*)d_out, (size_t)M * D); break; }
#endif
#if MK_SCAFFOLD
        if (ph == 4) {
            hipLaunchKernelGGL(sc_natten, dim3(M * NHEAD / 64), dim3(64), 0, stream, (const bf16_t*)(ws + WS_Q), (const bf16_t*)(ws + WS_K), (const bf16_t*)(ws + WS_V), (const float*)d_in[8], (bf16_t*)(ws + WS_AO));
            for (int dir = 0; dir < 2; ++dir)
                hipLaunchKernelGGL(sc_s5, dim3(NG, BATCH), dim3(64), 0, stream, (const bf16_t*)(ws + WS_U), (const float*)d_in[9], (const float*)d_in[10], (const float*)d_in[11], (const float*)d_in[12], (const float*)d_in[13],
                                   (const float*)d_in[14], (const float*)d_in[15], (float*)(ws + WS_YF), dir);
            hipLaunchKernelGGL(sc_comb, dim3((unsigned)((size_t)M * SW / 256)), dim3(256), 0, stream, (const bf16_t*)(ws + WS_U), (const float*)d_in[16], (const float*)(ws + WS_YF), (bf16_t*)(ws + WS_Y));
            continue;
        }
        if (ph == 5 || ph == 6) continue;
#endif
        a.ph_lo = ph; a.ph_hi = ph + 1;
        hipLaunchKernelGGL(mk_fwd, dim3(grid), dim3(512), LDS_BYTES, stream, a);
    }
#endif
}
```

```cpp
#include <hip/hip_runtime.h>
#include <cstdio>
#include <cstdint>

#ifndef MK_MODE
#define MK_MODE 1
#endif
#ifndef MK_SCAFFOLD
#define MK_SCAFFOLD 0
#endif
#ifndef PH_MASK
#define PH_MASK 0x3fff
#endif

#define LAS __attribute__((address_space(3)))
#define GAS __attribute__((address_space(1)))
typedef unsigned short bf16_t;
typedef short bf16x8 __attribute__((ext_vector_type(8)));
typedef float f32x4 __attribute__((ext_vector_type(4)));
typedef float f32x2 __attribute__((ext_vector_type(2)));
typedef unsigned u32x4 __attribute__((ext_vector_type(4)));
typedef unsigned u32x2 __attribute__((ext_vector_type(2)));

constexpr int BATCH = 4, SEQ = 8192, D = 1024, M = BATCH * SEQ, FF = 2816, NIN = 4096, AW = 512, SW = 512, PLE = 256;
constexpr int NHEAD = 8, HD = 64, GW = 64, ROWS = SEQ / GW;
constexpr int NG = 32, GC = 16, NP = 64, TC = 32, NC = SEQ / TC;
constexpr float RMS_EPS = 1e-6f;

constexpr size_t MiB = 1u << 20;
constexpr size_t WS_CTL = 0, CTL_ZERO_BYTES = 2 * MiB + 256 * 1024;
constexpr size_t WS_SS = 1 * MiB;
constexpr size_t WS_WGU1 = 3 * MiB, WS_WD1 = 14 * MiB, WS_WIN = 20 * MiB, WS_WGLU = 51 * MiB + 512 * 1024, WS_WOS = 28 * MiB, WS_WOUT = 30 * MiB;
constexpr size_t WS_WGU2 = 32 * MiB, WS_WD2 = 43 * MiB, WS_WPG = 49 * MiB, WS_WPP = 51 * MiB;
constexpr size_t WS_BT1 = 52 * MiB, WS_BT2 = 76 * MiB, WS_AT = 84 * MiB;
constexpr size_t WS_HB = 86 * MiB;
constexpr size_t DO_AO = 0, DO_YG = 32 * MiB;
constexpr size_t WS_H4 = 150 * MiB;
constexpr size_t WS_BIG = 150 * MiB;
constexpr size_t WS_ACT = WS_BIG;
constexpr size_t WS_PROJ = 342 * MiB;
constexpr size_t WS_PB = 486 * MiB;
constexpr size_t WS_Q = 150 * MiB, WS_K = 182 * MiB, WS_V = 214 * MiB, WS_U = 246 * MiB, WS_GA = 278 * MiB, WS_GS = 342 * MiB;
constexpr size_t WS_YI = 406 * MiB, WS_E = 438 * MiB, WS_XC = 470 * MiB;
constexpr size_t WS_Y = WS_V, WS_MRG = WS_Q;
constexpr size_t WS_YF = 406 * MiB;
constexpr size_t WS_END = 512 * MiB;
constexpr int CW_TMO = 0, CW_BAR = 4096;

constexpr int RING_BYTES = 131072, LDS_BYTES = 147456, MISC_OFF = LDS_BYTES - 256;

typedef __bf16 bf16x2_t __attribute__((ext_vector_type(2)));
__device__ __forceinline__ unsigned cvt_pk_bf16(float lo, float hi) { const f32x2 v = {lo, hi}; const bf16x2_t b = __builtin_convertvector(v, bf16x2_t); return __builtin_bit_cast(unsigned, b); }
__device__ __forceinline__ float bf_lo(unsigned w) { return __uint_as_float(w << 16); }
__device__ __forceinline__ float bf_hi(unsigned w) { return __uint_as_float(w & 0xffff0000u); }
__device__ __forceinline__ float bf2f(bf16_t b) { return __uint_as_float((unsigned)b << 16); }
__device__ __forceinline__ bf16_t f2bf(float f) { unsigned u = __float_as_uint(f); return (bf16_t)((u + 0x7fffu + ((u >> 16) & 1u)) >> 16); }
__device__ __forceinline__ float fsigmoid(float x) { return __builtin_amdgcn_rcpf(1.0f + __builtin_amdgcn_exp2f(-1.4426950408889634f * x)); }
__device__ __forceinline__ float gelu_tanh_f(float x) { return x * fsigmoid(1.5957691216057308f * (x + 0.044715f * x * x * x)); }
typedef unsigned long long u64;
constexpr float SS_SCALE = 1048576.0f;
__device__ __forceinline__ float rinv_of(u64 ss) { return 1.0f / sqrtf((float)ss * (1.0f / (SS_SCALE * D)) + RMS_EPS); }
__device__ __forceinline__ float rinv_f(float ss) { return 1.0f / sqrtf(ss * (1.0f / D) + RMS_EPS); }
__device__ __forceinline__ u64 ss_fix(float s) { return (u64)(s * SS_SCALE + 0.5f); }
__device__ __forceinline__ u32x4 pack8(f32x4 a, f32x4 b) { u32x4 w; w.x = cvt_pk_bf16(a[0], a[1]); w.y = cvt_pk_bf16(a[2], a[3]); w.z = cvt_pk_bf16(b[0], b[1]); w.w = cvt_pk_bf16(b[2], b[3]); return w; }
__device__ __forceinline__ void unpack8(u32x4 w, f32x4& a, f32x4& b) { a = (f32x4){bf_lo(w.x), bf_hi(w.x), bf_lo(w.y), bf_hi(w.y)}; b = (f32x4){bf_lo(w.z), bf_hi(w.z), bf_lo(w.w), bf_hi(w.w)}; }
__device__ __forceinline__ float sq8(f32x4 a, f32x4 b) { return (a[0] * a[0] + a[1] * a[1]) + (a[2] * a[2] + a[3] * a[3]) + (b[0] * b[0] + b[1] * b[1]) + (b[2] * b[2] + b[3] * b[3]); }

namespace pg8 {
constexpr int BM = 256, BK = 64, HALF = 128, HTB = HALF * BK * 2, STAGE_BYTES = 8 * HTB, NXCD = 8, WGM = 8;
__host__ __device__ __forceinline__ int lds_byte(int r, int c) { const int st = (r >> 4) * 2 + (c >> 5), rr = r & 15, cc = c & 31, ob = rr * 64 + cc * 2; return st * 1024 + (ob ^ (((ob >> 9) & 1) << 5)); }
__host__ __device__ __forceinline__ void stage_rc(int b, int& R, int& C) { const int st = b / 1024, sb = b % 1024, swz = sb ^ (((sb >> 9) & 1) << 5); R = (st >> 1) * 16 + swz / 64; C = (st & 1) * 32 + (swz % 64) / 2; }
__host__ __device__ __forceinline__ int perm32(int rho) { const int n = rho >> 4, i = rho & 15; return 8 * (i >> 2) + 4 * n + (i & 3); }

struct Unit { int pm, pn, grp; size_t aoff, boff; };
struct Gemm { const char* A; const char* Bt; int K; unsigned lda, ldb; unsigned kstepA; int amap; };

__device__ __forceinline__ bool static_tile(int L, int nM, int nN, int& pm, int& pn) {
    const int nwg = nM * nN; if (L >= nwg) return false;
    int wgid = L; { const int q = nwg / NXCD, r = nwg % NXCD, xcd = wgid % NXCD, off = wgid / NXCD; wgid = (xcd < r ? xcd * (q + 1) : r * (q + 1) + (xcd - r) * q) + off; }
    const int nig = WGM * nN, gid = wgid / nig, fm = gid * WGM, gsz = (nM - fm) < WGM ? (nM - fm) : WGM;
    pm = fm + ((wgid % nig) % gsz); pn = (wgid % nig) / gsz; return true;
}
struct PlainOrder {
    int nM, nN, G, c; unsigned lda, ldb;
    __device__ __forceinline__ bool next(int i, Unit& u) const {
        if (!static_tile(i * G + c, nM, nN, u.pm, u.pn)) return false;
        u.grp = 0; u.aoff = (size_t)u.pm * 256 * lda * 2; u.boff = (size_t)u.pn * 256 * ldb * 2; return true; }
};
struct MixOrder {
    int G, c; size_t a0, b0, a1, b1;
    __device__ __forceinline__ bool next(int i, Unit& u) const {
        const int L = i * G + c; constexpr int NGLU = (M / 256) * (SW / 256);
        if (L < NGLU) { if (!static_tile(L, M / 256, SW / 256, u.pm, u.pn)) return false; u.grp = 0; u.aoff = a0 + (size_t)u.pm * 256 * 512 * 2; u.boff = b0 + (size_t)u.pn * 256 * 512 * 2; return true; }
        if (!static_tile(L - NGLU, M / 256, D / 256, u.pm, u.pn)) return false; u.grp = 1; u.aoff = a1 + (size_t)u.pm * 256 * 512 * 2; u.boff = b1 + (size_t)u.pn * 256 * 512 * 2; return true; }
};
struct SsmOrder {
    int npn, G, c; size_t a_g, a_b, b_g, b_pn;
    __device__ __forceinline__ bool next(int i, Unit& u) const {
        const int L = i * G + c; if (L >= NG * BATCH * npn) return false;
        const int g = L / (BATCH * npn), rem = L % (BATCH * npn); u.grp = g; u.pn = rem / BATCH; u.pm = rem % BATCH;
        u.aoff = (size_t)g * a_g + (size_t)u.pm * a_b; u.boff = (size_t)g * b_g + (size_t)u.pn * b_pn; return true; }
};

template <class Epi, class Sched, bool ALIGN_EPI>
__device__ __forceinline__ void gemm_phase(LAS unsigned char* lds, const Gemm g, const Sched& S, const Epi& E) {
    const int tid = threadIdx.x, wid = __builtin_amdgcn_readfirstlane(tid >> 6), lane = tid & 63, wr = wid >> 2, wc = wid & 3, fr = lane & 15, fq = lane >> 4;
    int Kop = g.K; asm volatile("" : "+s"(Kop));
    const int nt = Kop / BK;
    unsigned voffA[2], voffB[2];
#pragma unroll
    for (int i = 0; i < 2; ++i) { int R, C; stage_rc(tid * 16 + i * 8192, R, C); const int Rb = (R & ~31) + perm32(R & 31);
        const int Ca = g.amap ? ((C >> 4) * 512 + (C & 15)) : C;
        voffA[i] = (unsigned)(R * (int)g.lda + Ca) * 2u; voffB[i] = (unsigned)(Rb * (int)g.ldb + C) * 2u; }
    const size_t kstepA = (size_t)g.kstepA, kstepB = (size_t)(BK * 2);
    const size_t hstepA = (size_t)HALF * g.lda * 2, hstepB = (size_t)HALF * g.ldb * 2;
    const unsigned ldsw = (unsigned)wid * 1024u;
    const int aoff = lds_byte(wr * 64 + fr, fq * 8), boff = lds_byte(wc * 32 + fr, fq * 8);
#define PG8_SA(b, h) (((b) * 2 + (h)) * HTB)
#define PG8_SB(b, h) ((4 + (b) * 2 + (h)) * HTB)
#define PG8_STAGE(bufoff, gbase, voff) do { _Pragma("unroll") for (int _i = 0; _i < 2; ++_i) \
        __builtin_amdgcn_global_load_lds((const unsigned*)((const char*)(gbase) + (voff)[_i]), (LAS unsigned*)(lds + (bufoff) + ldsw + _i * 8192), 16, 0, 0); } while (0)
#define PG8_LDA(dst, b, h) do { _Pragma("unroll") for (int m = 0; m < 4; ++m) _Pragma("unroll") for (int k = 0; k < 2; ++k) dst[m][k] = *(const LAS bf16x8*)(lds + PG8_SA(b, h) + aoff + m * 2048 + k * 1024); } while (0)
#define PG8_LDB(dst, b, h) do { _Pragma("unroll") for (int n = 0; n < 2; ++n) _Pragma("unroll") for (int k = 0; k < 2; ++k) dst[n][k] = *(const LAS bf16x8*)(lds + PG8_SB(b, h) + boff + n * 2048 + k * 1024); } while (0)
#define PG8_MMA(ai, bj, At, Bt) do { __builtin_amdgcn_s_setprio(1); _Pragma("unroll") for (int m = 0; m < 4; ++m) _Pragma("unroll") for (int n = 0; n < 2; ++n) _Pragma("unroll") for (int k = 0; k < 2; ++k) \
        acc[ai][bj][m][n] = __builtin_amdgcn_mfma_f32_16x16x32_bf16(Bt[n][k], At[m][k], acc[ai][bj][m][n], 0, 0, 0); __builtin_amdgcn_s_setprio(0); } while (0)
#define PG8_WAIT_V(n) asm volatile("s_waitcnt vmcnt(" #n ")" ::: "memory")
#define PG8_WAIT_L(n) asm volatile("s_waitcnt lgkmcnt(" #n ")" ::: "memory")
#define PG8_BAR __builtin_amdgcn_s_barrier()
#define PG8_SCHED __builtin_amdgcn_sched_barrier(0)
    Unit cur, nxt; int ui = 0;
    if (!S.next(0, cur)) return;
    f32x4 acc[2][2][4][2];
#pragma unroll
    for (int a = 0; a < 2; ++a)
#pragma unroll
        for (int b = 0; b < 2; ++b)
#pragma unroll
            for (int m = 0; m < 4; ++m)
#pragma unroll
                for (int n = 0; n < 2; ++n) acc[a][b][m][n] = (f32x4){0.f, 0.f, 0.f, 0.f};
    bf16x8 At[4][2], B0[2][2], B1[2][2];
    const char* cA = g.A + cur.aoff; const char* cB = g.Bt + cur.boff;
    PG8_STAGE(PG8_SB(0, 0), cB, voffB); PG8_STAGE(PG8_SB(0, 1), cB + hstepB, voffB); PG8_STAGE(PG8_SA(0, 0), cA, voffA); PG8_STAGE(PG8_SA(0, 1), cA + hstepA, voffA);
    if (wr == 1) PG8_BAR;
    PG8_WAIT_V(2); PG8_BAR;
    PG8_STAGE(PG8_SB(1, 0), cB + kstepB, voffB); PG8_STAGE(PG8_SA(1, 0), cA + kstepA, voffA); PG8_STAGE(PG8_SB(1, 1), cB + hstepB + kstepB, voffB);
    PG8_WAIT_V(6); PG8_BAR;
    for (;;) {
        const bool has_next = S.next(ui + 1, nxt);
        const char* nA = has_next ? g.A + nxt.aoff : cA; const char* nB = has_next ? g.Bt + nxt.boff : cB;
        for (int t = 0; t < nt; t += 2) {
            const bool last = (t == nt - 2);
            const char* a1 = cA + (size_t)(t + 1) * kstepA;
            const char* a2 = last ? nA : cA + (size_t)(t + 2) * kstepA; const char* b2 = last ? nB : cB + (size_t)(t + 2) * kstepB;
            const char* a3 = a2 + kstepA; const char* b3 = b2 + kstepB;
            PG8_LDB(B0, 0, 0); PG8_LDB(B1, 0, 1); PG8_SCHED; PG8_LDA(At, 0, 0); PG8_STAGE(PG8_SA(1, 1), a1 + hstepA, voffA);
            PG8_WAIT_V(8); PG8_WAIT_L(0); PG8_BAR; PG8_MMA(0, 0, At, B0); PG8_MMA(0, 1, At, B1); PG8_BAR; PG8_SCHED;
            PG8_LDA(At, 0, 1); PG8_STAGE(PG8_SB(0, 0), b2, voffB); PG8_STAGE(PG8_SB(0, 1), b2 + hstepB, voffB); PG8_STAGE(PG8_SA(0, 0), a2, voffA);
            PG8_WAIT_V(8); PG8_WAIT_L(0); PG8_BAR; PG8_MMA(1, 0, At, B0); PG8_MMA(1, 1, At, B1); PG8_BAR; PG8_SCHED;
            PG8_LDB(B0, 1, 0); PG8_LDB(B1, 1, 1); PG8_SCHED; PG8_LDA(At, 1, 0); PG8_STAGE(PG8_SA(0, 1), a2 + hstepA, voffA);
            PG8_WAIT_V(8); PG8_WAIT_L(0); PG8_BAR; PG8_MMA(0, 0, At, B0); PG8_MMA(0, 1, At, B1); PG8_BAR; PG8_SCHED;
            PG8_LDA(At, 1, 1); PG8_STAGE(PG8_SB(1, 0), b3, voffB); PG8_STAGE(PG8_SB(1, 1), b3 + hstepB, voffB); PG8_STAGE(PG8_SA(1, 0), a3, voffA);
            PG8_WAIT_V(8); PG8_WAIT_L(0); PG8_BAR; PG8_MMA(1, 0, At, B0); PG8_MMA(1, 1, At, B1); PG8_BAR; PG8_SCHED;
        }
        if constexpr (ALIGN_EPI) { if (wr == 0) PG8_BAR; }
        E(acc, cur, wr, wc, fr, fq);
        if (!has_next) break;
#pragma unroll
        for (int a = 0; a < 2; ++a)
#pragma unroll
            for (int b = 0; b < 2; ++b)
#pragma unroll
                for (int m = 0; m < 4; ++m)
#pragma unroll
                    for (int n = 0; n < 2; ++n) acc[a][b][m][n] = (f32x4){0.f, 0.f, 0.f, 0.f};
        cur = nxt; cA = nA; cB = nB; ++ui;
        if constexpr (ALIGN_EPI) { if (wr == 1) PG8_BAR; }
    }
    PG8_WAIT_V(0);
    if constexpr (!ALIGN_EPI) { if (wr == 0) PG8_BAR; }
    PG8_BAR;
#undef PG8_SA
#undef PG8_SB
#undef PG8_STAGE
#undef PG8_LDA
#undef PG8_LDB
#undef PG8_MMA
#undef PG8_WAIT_V
#undef PG8_WAIT_L
#undef PG8_BAR
#undef PG8_SCHED
}
}

typedef f32x4 AccT[2][2][4][2];
using pg8::Unit;
struct EpiSwiglu { bf16_t* act; const u64* ss;
    __device__ __forceinline__ void operator()(const AccT& acc, const Unit& u, int wr, int wc, int fr, int fq) const {
        const int row0 = u.pm * 256 + wr * 64 + fr, col0 = u.pn * 128 + wc * 32 + 8 * fq;
#pragma unroll
        for (int ai = 0; ai < 2; ++ai)
#pragma unroll
            for (int m = 0; m < 4; ++m) { const int row = row0 + ai * 128 + m * 16; const float rr = rinv_of(ss[row]);
                f32x4 o[2];
#pragma unroll
                for (int n = 0; n < 2; ++n)
#pragma unroll
                    for (int e = 0; e < 4; ++e) { const float gv = acc[ai][0][m][n][e] * rr, uv = acc[ai][1][m][n][e] * rr; o[n][e] = gv * fsigmoid(gv) * uv; }
                *(u32x4*)(act + (size_t)row * FF + col0) = pack8(o[0], o[1]); }
    }
};
struct EpiResid { bf16_t* hb; u64* ssn; float alpha;
    __device__ __forceinline__ void operator()(const AccT& acc, const Unit& u, int wr, int wc, int fr, int fq) const {
        const int row0 = u.pm * 256 + wr * 64 + fr, col0 = u.pn * 256 + wc * 32 + 8 * fq;
#pragma unroll
        for (int ai = 0; ai < 2; ++ai)
#pragma unroll
            for (int m = 0; m < 4; ++m) { const int row = row0 + ai * 128 + m * 16; float sq = 0.f;
#pragma unroll
                for (int bj = 0; bj < 2; ++bj) { const size_t off = (size_t)row * D + col0 + bj * 128;
                    f32x4 b0, b1; unpack8(*(const u32x4*)(hb + off), b0, b1);
                    const f32x4 h0 = b0 + alpha * acc[ai][bj][m][0], h1 = b1 + alpha * acc[ai][bj][m][1];
                    *(u32x4*)(hb + off) = pack8(h0, h1); sq += sq8(h0, h1); }
                sq += __shfl_xor(sq, 16); sq += __shfl_xor(sq, 32);
                if (fq == 0) atomicAdd(ssn + row, ss_fix(sq));
                asm volatile("" ::: "memory"); }
    }
};
struct EpiWin { bf16_t* qkvu; bf16_t* gg; const u64* ss;
    __device__ __forceinline__ void operator()(const AccT& acc, const Unit& u, int wr, int wc, int fr, int fq) const {
        const int row0 = u.pm * 256 + wr * 64 + fr; const int pn = u.pn;
        if (pn < 8) { const int t = pn >> 1; bf16_t* dst = qkvu + (size_t)t * M * 512; const int col0 = (pn & 1) * 256 + wc * 32 + 8 * fq; const float sc = (t == 0) ? 0.125f : 1.0f;
#pragma unroll
            for (int ai = 0; ai < 2; ++ai)
#pragma unroll
                for (int m = 0; m < 4; ++m) { const int row = row0 + ai * 128 + m * 16; const float rr = rinv_of(ss[row]) * sc;
#pragma unroll
                    for (int bj = 0; bj < 2; ++bj) *(u32x4*)(dst + (size_t)row * 512 + col0 + bj * 128) = pack8(acc[ai][bj][m][0] * rr, acc[ai][bj][m][1] * rr); }
        } else { const int w = (pn - 8) >> 2; bf16_t* dst = gg + (size_t)w * M * D; const int col0 = ((pn - 8) & 3) * 256 + wc * 32 + 8 * fq;
#pragma unroll
            for (int ai = 0; ai < 2; ++ai)
#pragma unroll
                for (int m = 0; m < 4; ++m) { const int row = row0 + ai * 128 + m * 16; const float rr = rinv_of(ss[row]);
#pragma unroll
                    for (int bj = 0; bj < 2; ++bj) { f32x4 o[2];
#pragma unroll
                        for (int n = 0; n < 2; ++n)
#pragma unroll
                            for (int e = 0; e < 4; ++e) o[n][e] = fsigmoid(acc[ai][bj][m][n][e] * rr);
                        *(u32x4*)(dst + (size_t)row * D + col0 + bj * 128) = pack8(o[0], o[1]); } }
        }
    }
};
struct EpiSsm1 { bf16_t* yi; float* E;
    __device__ __forceinline__ void operator()(const AccT& acc, const Unit& u, int wr, int wc, int fr, int fq) const {
        const int g = u.grp, b = u.pm;
#pragma unroll
        for (int ai = 0; ai < 2; ++ai)
#pragma unroll
            for (int m = 0; m < 4; ++m) { const int c = ai * 128 + wr * 64 + m * 16 + fr;
#pragma unroll
                for (int bj = 0; bj < 2; ++bj) { const int n = bj * 128 + wc * 32 + 8 * fq;
                    if (u.pn < 2) { const int nn = u.pn * 256 + n, tau = nn >> 4, o = nn & 15;
                        *(u32x4*)(yi + ((size_t)b * SEQ + c * TC + tau) * SW + g * GC + o) = pack8(acc[ai][bj][m][0], acc[ai][bj][m][1]); }
                    else { float* e = E + ((size_t)(g * BATCH + b) * NC + c) * 256 + n; *(f32x4*)e = acc[ai][bj][m][0]; *(f32x4*)(e + 4) = acc[ai][bj][m][1]; } } }
    }
};
struct EpiSsm2 { const bf16_t* yi; bf16_t* y;
    __device__ __forceinline__ void operator()(const AccT& acc, const Unit& u, int wr, int wc, int fr, int fq) const {
        const int g = u.grp, b = u.pm;
#pragma unroll
        for (int ai = 0; ai < 2; ++ai)
#pragma unroll
            for (int m = 0; m < 4; ++m) { const int c = ai * 128 + wr * 64 + m * 16 + fr;
#pragma unroll
                for (int bj = 0; bj < 2; ++bj) { const int nn = u.pn * 256 + bj * 128 + wc * 32 + 8 * fq, tau = nn >> 4, o = nn & 15;
                    const size_t off = ((size_t)b * SEQ + c * TC + tau) * SW + g * GC + o;
                    f32x4 i0, i1; unpack8(*(const u32x4*)(yi + off), i0, i1); i0 += acc[ai][bj][m][0]; i1 += acc[ai][bj][m][1];
#pragma unroll
                    for (int e = 0; e < 4; ++e) { i0[e] = gelu_tanh_f(i0[e]); i1[e] = gelu_tanh_f(i1[e]); }
                    *(u32x4*)(y + off) = pack8(i0, i1); }
                asm volatile("" ::: "memory"); }
    }
};
struct EpiMix { const bf16_t* y; bf16_t* yg; const float* bias; const bf16_t* ga; bf16_t* mrg;
    __device__ __forceinline__ void operator()(const AccT& acc, const Unit& u, int wr, int wc, int fr, int fq) const {
        const int row0 = u.pm * 256 + wr * 64 + fr, col0 = u.pn * 256 + wc * 32 + 8 * fq;
        if (u.grp == 0) {
#pragma unroll
            for (int bj = 0; bj < 2; ++bj) { const f32x4 bv0 = *(const f32x4*)(bias + col0 + bj * 128), bv1 = *(const f32x4*)(bias + col0 + bj * 128 + 4);
#pragma unroll
                for (int ai = 0; ai < 2; ++ai)
#pragma unroll
                    for (int m = 0; m < 4; ++m) { const size_t off = (size_t)(row0 + ai * 128 + m * 16) * SW + col0 + bj * 128;
                        f32x4 y0, y1; unpack8(*(const u32x4*)(y + off), y0, y1); const f32x4 t0 = acc[ai][bj][m][0] + bv0, t1 = acc[ai][bj][m][1] + bv1;
#pragma unroll
                        for (int e = 0; e < 4; ++e) { y0[e] *= fsigmoid(t0[e]); y1[e] *= fsigmoid(t1[e]); }
                        *(u32x4*)(yg + off) = pack8(y0, y1);
                        asm volatile("" ::: "memory"); } }
        } else {
#pragma unroll
            for (int ai = 0; ai < 2; ++ai)
#pragma unroll
                for (int m = 0; m < 4; ++m)
#pragma unroll
                    for (int bj = 0; bj < 2; ++bj) { const size_t off = (size_t)(row0 + ai * 128 + m * 16) * D + col0 + bj * 128;
                        f32x4 g0, g1; unpack8(*(const u32x4*)(ga + off), g0, g1);
                        *(u32x4*)(mrg + off) = pack8(g0 * acc[ai][bj][m][0], g1 * acc[ai][bj][m][1]);
                        asm volatile("" ::: "memory"); }
        }
    }
};
struct EpiSsmProj { const bf16_t* gs; bf16_t* mrg;
    __device__ __forceinline__ void operator()(const AccT& acc, const Unit& u, int wr, int wc, int fr, int fq) const {
        const int row0 = u.pm * 256 + wr * 64 + fr, col0 = u.pn * 256 + wc * 32 + 8 * fq;
#pragma unroll
        for (int ai = 0; ai < 2; ++ai)
#pragma unroll
            for (int m = 0; m < 4; ++m)
#pragma unroll
                for (int bj = 0; bj < 2; ++bj) { const size_t off = (size_t)(row0 + ai * 128 + m * 16) * D + col0 + bj * 128;
                    f32x4 g0, g1, p0, p1; unpack8(*(const u32x4*)(gs + off), g0, g1); unpack8(*(const u32x4*)(mrg + off), p0, p1);
                    *(u32x4*)(mrg + off) = pack8(p0 + g0 * acc[ai][bj][m][0], p1 + g1 * acc[ai][bj][m][1]);
                    asm volatile("" ::: "memory"); }
    }
};
struct EpiStoreBf16 { bf16_t* out;
    __device__ __forceinline__ void operator()(const AccT& acc, const Unit& u, int wr, int wc, int fr, int fq) const {
        const int row0 = u.pm * 256 + wr * 64 + fr, col0 = u.pn * 256 + wc * 32 + 8 * fq;
#pragma unroll
        for (int ai = 0; ai < 2; ++ai)
#pragma unroll
            for (int m = 0; m < 4; ++m)
#pragma unroll
                for (int bj = 0; bj < 2; ++bj) *(u32x4*)(out + (size_t)(row0 + ai * 128 + m * 16) * D + col0 + bj * 128) = pack8(acc[ai][bj][m][0], acc[ai][bj][m][1]);
    }
};
struct EpiPleGate { const bf16_t* hb; const bf16_t* proj; const u64* ss; bf16_t* h4; u64* ssn;
    __device__ __forceinline__ void operator()(const AccT& acc, const Unit& u, int wr, int wc, int fr, int fq) const {
        const int row0 = u.pm * 256 + wr * 64 + fr, col0 = u.pn * 256 + wc * 32 + 8 * fq;
#pragma unroll
        for (int ai = 0; ai < 2; ++ai)
#pragma unroll
            for (int m = 0; m < 4; ++m) { const int row = row0 + ai * 128 + m * 16; const float rr = rinv_of(ss[row]); float sq = 0.f;
#pragma unroll
                for (int bj = 0; bj < 2; ++bj) { const size_t off = (size_t)row * D + col0 + bj * 128; f32x4 pj[2], hv[2]; unpack8(*(const u32x4*)(proj + off), pj[0], pj[1]); unpack8(*(const u32x4*)(hb + off), hv[0], hv[1]);
#pragma unroll
                    for (int n = 0; n < 2; ++n)
#pragma unroll
                        for (int e = 0; e < 4; ++e) hv[n][e] += pj[n][e] * fsigmoid(acc[ai][bj][m][n][e] * rr);
                    *(u32x4*)(h4 + off) = pack8(hv[0], hv[1]); sq += sq8(hv[0], hv[1]); }
                sq += __shfl_xor(sq, 16); sq += __shfl_xor(sq, 32);
                if (fq == 0) atomicAdd(ssn + row, ss_fix(sq));
                asm volatile("" ::: "memory"); }
    }
};

#define XB_TMO      128
#define XB_XCNT(j)  (256  + 64 * (j))
#define XB_XSUB(j)  (1280 + 64 * (j))
#define XB_XGEN(j)  (2304 + 64 * (j))
#define XB_TOP      3328
#define XB_TOPGEN   3392
#define XCD_BAR_WORDS 3456
#define XB_SPIN_CAP (1u << 18)
__device__ __forceinline__ unsigned xb_ld(unsigned* p)              { return __hip_atomic_load(p, __ATOMIC_RELAXED, __HIP_MEMORY_SCOPE_AGENT); }
__device__ __forceinline__ unsigned xb_add(unsigned* p, unsigned v) { return __hip_atomic_fetch_add(p, v, __ATOMIC_RELAXED, __HIP_MEMORY_SCOPE_AGENT); }
__device__ __forceinline__ unsigned xb_xcc_id() { return (unsigned)__builtin_amdgcn_s_getreg((3 << 11) | 20) & 0xFu; }
#define XB_SPIN(cond, bar) do { unsigned _sp = 0; while (cond) { __builtin_amdgcn_s_sleep(1); \
    if ((++_sp & 255u) == 0u) { if (xb_ld(&(bar)[XB_TMO])) break; if (_sp > XB_SPIN_CAP) { atomicAdd(&(bar)[XB_TMO], 1u); break; } } } } while (0)
struct XcdBarrier { unsigned* bar; unsigned x; volatile LAS unsigned* st; };
__device__ __forceinline__ XcdBarrier xcd_barrier_post(unsigned* bar, volatile LAS unsigned* st) {
    XcdBarrier b; b.bar = bar; b.x = xb_xcc_id(); b.st = st;
    if (threadIdx.x == 0) (void)xb_add(&bar[XB_XCNT(b.x)], 1u);
    return b;
}
__device__ __forceinline__ void xcd_barrier_complete(unsigned* bar, unsigned x, unsigned& nloc, unsigned& nx) {
    const unsigned G = gridDim.x * gridDim.y * gridDim.z;
    unsigned sum, cnt, mine, sp = 0u;
    for (;;) {
        sum = 0u; cnt = 0u; mine = 0u;
#pragma unroll
        for (unsigned j = 0; j < 16; ++j) { const unsigned c = xb_ld(&bar[XB_XCNT(j)]); sum += c; cnt += (c > 0u) ? 1u : 0u; mine = (j == x) ? c : mine; }
        if (sum == G) break;
        __builtin_amdgcn_s_sleep(1);
        if ((++sp & 255u) == 0u) { if (xb_ld(&bar[XB_TMO])) break; if (sp > XB_SPIN_CAP) { atomicAdd(&bar[XB_TMO], 1u); break; } }
    }
    nloc = mine > 0u ? mine : 1u; nx = cnt > 0u ? cnt : 1u;
}
__device__ __forceinline__ void xcd_barrier(const XcdBarrier& b) {
    asm volatile("s_waitcnt vmcnt(0)" ::: "memory");
    __syncthreads();
    if (threadIdx.x == 0) {
        unsigned* bar = b.bar;
        __builtin_amdgcn_s_waitcnt(0);
        unsigned nloc = b.st[0], nx = b.st[1];
        if (nloc == 0u) { xcd_barrier_complete(bar, b.x, nloc, nx); b.st[0] = nloc; b.st[1] = nx; }
        const unsigned old = xb_add(&bar[XB_XSUB(b.x)], 1u);
        const unsigned gen = old / nloc;
        if (old + 1u == (gen + 1u) * nloc) {
            __builtin_amdgcn_fence(__ATOMIC_RELEASE, "agent");
            asm volatile("s_waitcnt vmcnt(0)" ::: "memory");
            const unsigned og = xb_add(&bar[XB_TOP], 1u);
            const unsigned tg = og / nx;
            if (og + 1u == (tg + 1u) * nx) xb_add(&bar[XB_TOPGEN], 1u);
            else XB_SPIN(xb_ld(&bar[XB_TOPGEN]) == tg, bar);
            __builtin_amdgcn_fence(__ATOMIC_ACQUIRE, "agent");
            xb_add(&bar[XB_XGEN(b.x)], 1u);
            asm volatile("s_waitcnt vmcnt(0)" ::: "memory");
        } else {
            XB_SPIN(xb_ld(&bar[XB_XGEN(b.x)]) == gen, bar);
            __builtin_amdgcn_fence(__ATOMIC_ACQUIRE, "agent");
            asm volatile("s_waitcnt vmcnt(0)" ::: "memory");
        }
    }
    __syncthreads();
}

#define LDS_WAIT() asm volatile("s_waitcnt lgkmcnt(0)" ::: "memory")
__device__ __forceinline__ unsigned pk2(float lo, float hi) { return (unsigned)f2bf(lo) | ((unsigned)f2bf(hi) << 16); }
constexpr int P0_SCR_BYTES = 17408;
__device__ __forceinline__ void p0_transpose_item(const float* W, int K, int N, bf16_t* WT, int grp, int gstride, int goff, const float* gain, LAS float* scr, int item, int lane) {
    const int nblk = N / 64, kb = item / nblk, nb = item % nblk, k0 = 64 * kb, n0 = 64 * nb, kq = lane >> 4, nq = lane & 15;
    f32x4 v[16];
#pragma unroll
    for (int i = 0; i < 16; ++i) v[i] = *(const f32x4*)(W + (size_t)(k0 + 4 * i + kq) * N + n0 + 4 * nq);
#pragma unroll
    for (int i = 0; i < 16; ++i) { const float gsc = gain ? gain[k0 + 4 * i + kq] : 1.0f; LAS float* d = scr + (4 * i + kq) * 65 + 4 * nq; d[0] = v[i][0] * gsc; d[1] = v[i][1] * gsc; d[2] = v[i][2] * gsc; d[3] = v[i][3] * gsc; }
    LDS_WAIT(); asm volatile("" ::: "memory");
    const int c = lane & 7;
#pragma unroll
    for (int j = 0; j < 8; ++j) { const int n = (lane >> 3) + 8 * j; const LAS float* sp = scr + (8 * c) * 65 + n; const int nn = n0 + n, dr = (nn / grp) * gstride + goff + nn % grp;
        u32x4 o; o.x = cvt_pk_bf16(sp[0 * 65], sp[1 * 65]); o.y = cvt_pk_bf16(sp[2 * 65], sp[3 * 65]); o.z = cvt_pk_bf16(sp[4 * 65], sp[5 * 65]); o.w = cvt_pk_bf16(sp[6 * 65], sp[7 * 65]);
        *(u32x4*)(WT + (size_t)dr * K + k0 + 8 * c) = o; }
    LDS_WAIT(); asm volatile("" ::: "memory");
}
__device__ __forceinline__ float wave_sum(float v) {
#pragma unroll
    for (int o = 1; o < 64; o <<= 1) v += __shfl_xor(v, o);
    return v;
}
__device__ __forceinline__ void p0_ssm_group(LAS unsigned char* lds, int g, int dir, const float* lam_re, const float* lam_im, const float* log_dt, const float* b_re, const float* b_im,
                                              const float* c_re, const float* c_im, const float* dsk, bf16_t* Bt1, bf16_t* Bt2, f32x2* aT) {
    LAS f32x2* bb = (LAS f32x2*)lds; LAS f32x2* ap = (LAS f32x2*)(lds + 16384); LAS f32x2* cc = (LAS f32x2*)(lds + 33280); LAS float* kt = (LAS float*)(lds + 49664);
    const int tid = threadIdx.x;
    if (tid < 128) {
        const int own = (tid < 64), d = own ? dir : 1 - dir, p = tid & 63, gp = (d * NG + g) * NP + p, sl = own ? 0 : 1;
        const double lr = fmin((double)lam_re[gp], -1e-4), li = (double)lam_im[gp], dt = exp((double)log_dt[d * NG + g]);
        const double er = exp(lr * dt), ar = er * cos(li * dt), ai = er * sin(li * dt);
        const double nr = ar - 1.0, ni = ai, den = lr * lr + li * li;
        const double fr = (nr * lr + ni * li) / den, fi = (ni * lr - nr * li) / den;
        for (int i = 0; i < GC; ++i) { const double br = b_re[(size_t)gp * GC + i], bi = b_im[(size_t)gp * GC + i]; bb[(sl * 64 + p) * 16 + i] = (f32x2){(float)(fr * br - fi * bi), (float)(fr * bi + fi * br)}; }
        if (own) { double pr = 1.0, pi = 0.0;
            for (int k = 0; k <= TC; ++k) { ap[p * 33 + k] = (f32x2){(float)pr, (float)pi}; const double t = pr * ar - pi * ai; pi = pr * ai + pi * ar; pr = t; }
            aT[gp] = ap[p * 33 + TC]; }
    }
    for (int e = tid; e < 2 * 16 * 64; e += 512) { const int sl = e >> 10, o = (e >> 6) & 15, p = e & 63, d = sl ? 1 - dir : dir; const size_t ci = ((size_t)(d * NG + g) * GC + o) * NP + p; cc[(sl * 64 + p) * 16 + o] = (f32x2){c_re[ci], c_im[ci]}; }
    __syncthreads();
    for (int e = tid; e < 33 * 16 * 4; e += 512) { const int i4 = (e & 3) * 4, o = (e >> 2) & 15, k = e >> 6, sl = (k == 32) ? 1 : 0;
        float s0 = 0.f, s1 = 0.f, s2 = 0.f, s3 = 0.f;
        for (int p = 0; p < 64; ++p) { const f32x2 c = cc[(sl * 64 + p) * 16 + o]; float wr_ = c.x, wi_ = c.y;
            if (!sl) { const f32x2 a = ap[p * 33 + k]; wr_ = c.x * a.x - c.y * a.y; wi_ = c.x * a.y + c.y * a.x; }
            const LAS f32x2* b = bb + (sl * 64 + p) * 16 + i4;
            s0 += wr_ * b[0].x - wi_ * b[0].y; s1 += wr_ * b[1].x - wi_ * b[1].y; s2 += wr_ * b[2].x - wi_ * b[2].y; s3 += wr_ * b[3].x - wi_ * b[3].y; }
        LAS float* dd = kt + (k * 16 + o) * 16 + i4; dd[0] = s0; dd[1] = s1; dd[2] = s2; dd[3] = s3; }
    __syncthreads();
    bf16_t* B1 = Bt1 + (size_t)g * 768 * 512;
    for (int e = tid; e < 512 * 64; e += 512) { const int n = e >> 6, k8 = (e & 63) * 8, tau = n >> 4, o = n & 15, sg = k8 >> 4, i0 = k8 & 15;
        const bool mine = (dir == 0) ? (tau >= sg) : (tau < sg); if (!mine) continue;
        float v[8];
        if (tau != sg) { const int lag = tau > sg ? tau - sg : sg - tau; const LAS float* sp = kt + (lag * 16 + o) * 16 + i0;
#pragma unroll
            for (int j = 0; j < 8; ++j) v[j] = sp[j]; }
        else { const LAS float* s0 = kt + (0 * 16 + o) * 16 + i0; const LAS float* s1 = kt + (32 * 16 + o) * 16 + i0; const float dd = dsk[g * GC + o];
#pragma unroll
            for (int j = 0; j < 8; ++j) v[j] = s0[j] + s1[j] + ((i0 + j) == o ? dd : 0.f); }
        u32x4 w; w.x = pk2(v[0], v[1]); w.y = pk2(v[2], v[3]); w.z = pk2(v[4], v[5]); w.w = pk2(v[6], v[7]);
        *(u32x4*)(B1 + (size_t)n * 512 + k8) = w; }
    for (int e = tid; e < 128 * 64; e += 512) { const int r = e >> 6, k8 = (e & 63) * 8, im = r >> 6, p = r & 63, sg = k8 >> 4, i0 = k8 & 15;
        const f32x2 a = ap[p * 33 + (dir == 0 ? (TC - 1 - sg) : sg)]; float v[8];
#pragma unroll
        for (int j = 0; j < 8; ++j) { const f32x2 b = bb[p * 16 + i0 + j]; v[j] = im ? (a.x * b.y + a.y * b.x) : (a.x * b.x - a.y * b.y); }
        u32x4 w; w.x = pk2(v[0], v[1]); w.y = pk2(v[2], v[3]); w.z = pk2(v[4], v[5]); w.w = pk2(v[6], v[7]);
        *(u32x4*)(B1 + (size_t)(512 + 128 * dir + r) * 512 + k8) = w; }
    bf16_t* B2 = Bt2 + (size_t)g * 512 * 256;
    for (int e = tid; e < 512 * 16; e += 512) { const int n = e >> 4, k8 = (e & 15) * 8, tau = n >> 4, o = n & 15, im = k8 >> 6, p0 = k8 & 63; float v[8];
#pragma unroll
        for (int j = 0; j < 8; ++j) { const int p = p0 + j; const f32x2 c = cc[p * 16 + o], a = ap[p * 33 + (dir == 0 ? tau + 1 : TC - tau)];
            v[j] = im ? -(c.x * a.y + c.y * a.x) : (c.x * a.x - c.y * a.y); }
        u32x4 w; w.x = pk2(v[0], v[1]); w.y = pk2(v[2], v[3]); w.z = pk2(v[4], v[5]); w.w = pk2(v[6], v[7]);
        *(u32x4*)(B2 + (size_t)n * 256 + 128 * dir + k8) = w; }
    __syncthreads();
}

typedef short s16x4 __attribute__((ext_vector_type(4)));
__device__ __forceinline__ s16x4 tr_read(const LAS unsigned char* p) { return __builtin_bit_cast(s16x4, __builtin_amdgcn_ds_read_tr16_b64_v4i16((LAS s16x4*)p)); }
constexpr int ATT_V_BYTES = 9 * 64 * 128, ATT_RPB_OFF = ATT_V_BYTES;
__device__ __forceinline__ void attn_phase(LAS unsigned char* lds, const bf16_t* __restrict__ Q, const bf16_t* __restrict__ Kg, const bf16_t* __restrict__ Vg, const float* __restrict__ rpb, bf16_t* __restrict__ AO, int G, int bx) {
    const int tid = threadIdx.x, lane = tid & 63, w = __builtin_amdgcn_readfirstlane(tid >> 6), g4 = lane >> 4, l15 = lane & 15;
    LAS float* rp = (LAS float*)(lds + ATT_RPB_OFF);
    constexpr int NUNITS = BATCH * NHEAD * (ROWS / 2);
    for (int un = bx; un < NUNITS; un += G) {
        const int per = (NUNITS + G - 1) / G; const int u2 = (un % G) * per + un / G; if (u2 >= NUNITS) continue;
        const int bh = u2 / (ROWS / 2), rpair = u2 % (ROWS / 2), b = bh >> 3, h = bh & 7, r0 = 2 * rpair;
        int rsu = r0 - 4; rsu = rsu < 0 ? 0 : (rsu > ROWS - 8 ? ROWS - 8 : rsu);
        __syncthreads();
        { const int t = tid >> 3, c = tid & 7;
#pragma unroll
          for (int j = 0; j < 9; ++j) { const int row = rsu + j; if (row < ROWS) { const u32x4 v = *(const u32x4*)(Vg + ((size_t)b * SEQ + row * GW + t) * AW + h * HD + c * 8);
              *(LAS u32x4*)(lds + (j * 64 + t) * 128 + ((c ^ (t & 7)) << 4)) = v; } }
          if (tid < 465) rp[tid] = rpb[h * 465 + tid]; }
        const int r = r0 + (w >> 2), c0 = (w & 3) * 16;
        int rs = r - 4; rs = rs < 0 ? 0 : (rs > ROWS - 8 ? ROWS - 8 : rs);
        int wst = c0 - 8; wst = wst < 0 ? 0 : (wst > 32 ? 32 : wst);
        const size_t tq = (size_t)b * SEQ + r * GW + c0 + l15;
        bf16x8 qf[2];
#pragma unroll
        for (int kk = 0; kk < 2; ++kk) qf[kk] = *(const bf16x8*)(Q + tq * AW + h * HD + 8 * g4 + 32 * kk);
        f32x4 sacc[8][2];
        const bf16_t* kbase = Kg + ((size_t)b * SEQ + rs * GW + wst + l15) * AW + h * HD + 8 * g4;
#pragma unroll
        for (int kr = 0; kr < 8; ++kr)
#pragma unroll
            for (int nb = 0; nb < 2; ++nb) { f32x4 a = {0.f, 0.f, 0.f, 0.f};
#pragma unroll
                for (int kk = 0; kk < 2; ++kk) { const bf16x8 kf = *(const bf16x8*)(kbase + (size_t)(kr * GW + nb * 16) * AW + 32 * kk); a = __builtin_amdgcn_mfma_f32_16x16x32_bf16(kf, qf[kk], a, 0, 0, 0); }
                sacc[kr][nb] = a; }
        __syncthreads();
        const int c = c0 + l15; int cs = c - 8; cs = cs < 0 ? 0 : (cs > GW - 16 ? GW - 16 : cs);
        float mx = -1e30f;
#pragma unroll
        for (int kr = 0; kr < 8; ++kr) { const LAS float* brow = rp + (rs + kr - r + 7) * 31;
#pragma unroll
            for (int nb = 0; nb < 2; ++nb)
#pragma unroll
                for (int e = 0; e < 4; ++e) { const int kc = wst + 16 * nb + 4 * g4 + e; const bool ok = (kc >= cs) && (kc < cs + 16); const int dc = ok ? (kc - c + 15) : 0;
                    const float sv = ok ? sacc[kr][nb][e] + brow[dc] : -1e30f; sacc[kr][nb][e] = sv; mx = fmaxf(mx, sv); } }
        mx = fmaxf(mx, __shfl_xor(mx, 16)); mx = fmaxf(mx, __shfl_xor(mx, 32));
        float sum = 0.f; bf16x8 pb[8];
#pragma unroll
        for (int kr = 0; kr < 8; ++kr) { float pv[8];
#pragma unroll
            for (int nb = 0; nb < 2; ++nb)
#pragma unroll
                for (int e = 0; e < 4; ++e) { const float p = __builtin_amdgcn_exp2f((sacc[kr][nb][e] - mx) * 1.4426950408889634f); pv[nb * 4 + e] = p; sum += p; }
            u32x4 wv; wv.x = cvt_pk_bf16(pv[0], pv[1]); wv.y = cvt_pk_bf16(pv[2], pv[3]); wv.z = cvt_pk_bf16(pv[4], pv[5]); wv.w = cvt_pk_bf16(pv[6], pv[7]);
            pb[kr] = __builtin_bit_cast(bf16x8, wv); }
        sum += __shfl_xor(sum, 16); sum += __shfl_xor(sum, 32);
        f32x4 oacc[4];
#pragma unroll
        for (int d = 0; d < 4; ++d) oacc[d] = (f32x4){0.f, 0.f, 0.f, 0.f};
        const int q4 = (lane >> 2) & 3, p4 = lane & 3;
#pragma unroll
        for (int kr = 0; kr < 8; ++kr) { const int slot = rs + kr - rsu;
            const int t0 = wst + 4 * g4 + q4, t1 = t0 + 16;
            const LAS unsigned char* row0 = lds + (slot * 64 + t0) * 128 + (p4 & 1) * 8; const LAS unsigned char* row1 = lds + (slot * 64 + t1) * 128 + (p4 & 1) * 8;
#pragma unroll
            for (int d = 0; d < 4; ++d) { const int ch = 2 * d + (p4 >> 1);
                const s16x4 v0 = tr_read(row0 + ((ch ^ (t0 & 7)) << 4)), v1 = tr_read(row1 + ((ch ^ (t1 & 7)) << 4));
                bf16x8 vf; vf[0] = v0[0]; vf[1] = v0[1]; vf[2] = v0[2]; vf[3] = v0[3]; vf[4] = v1[0]; vf[5] = v1[1]; vf[6] = v1[2]; vf[7] = v1[3];
                oacc[d] = __builtin_amdgcn_mfma_f32_16x16x32_bf16(vf, pb[kr], oacc[d], 0, 0, 0); } }
        const float inv = 1.0f / sum;
#pragma unroll
        for (int d = 0; d < 4; ++d) { const f32x4 o = oacc[d] * inv; *(u32x2*)(AO + tq * AW + h * HD + 16 * d + 4 * g4) = (u32x2){cvt_pk_bf16(o[0], o[1]), cvt_pk_bf16(o[2], o[3])}; }
    }
    __syncthreads();
}

struct Args { const float* in[30]; float* out; unsigned char* ws; int ph_lo, ph_hi; };
constexpr int N_PHASES = 14;

__global__ void __launch_bounds__(512, 2) mk_fwd(Args args) {
    extern __shared__ __attribute__((aligned(16))) unsigned char lds_raw[];
    LAS unsigned char* lds = (LAS unsigned char*)lds_raw;
    volatile LAS unsigned* MISC = (volatile LAS unsigned*)(lds + MISC_OFF);
    const int tid = threadIdx.x, lane = tid & 63, wave = __builtin_amdgcn_readfirstlane(tid >> 6);
    const int G = gridDim.x, bx = blockIdx.x;
    unsigned char* ws = args.ws;
    unsigned* ctl = (unsigned*)(ws + WS_CTL);
    u64* ss0 = (u64*)(ws + WS_SS); u64* ss1 = ss0 + M; u64* ss2 = ss1 + M; u64* ss3 = ss2 + M; u64* ss4 = ss3 + M;
    unsigned char* dob = (unsigned char*)args.out;
    bf16_t* HB = (bf16_t*)(ws + WS_HB);
    const int lo = args.ph_lo, hi = args.ph_hi;
#define IN(k) (((PH_MASK >> (k)) & 1) && lo <= (k) && (k) < hi)
#define BOTH(k) (IN(k) && IN((k) + 1))
    for (int u = tid; u < 64; u += 512) MISC[u] = 0u;
    __syncthreads();
    XcdBarrier bar; bar.bar = ctl + CW_BAR; bar.x = 0; bar.st = nullptr;
    if (hi - lo > 1) bar = xcd_barrier_post(ctl + CW_BAR, MISC + 8);
#define GRID_BAR() xcd_barrier(bar)
#ifdef TS_SEL
    unsigned long long* tsw = (unsigned long long*)(ctl + 2048);
#define STAMP(k) do { if (bx == 0 && tid == 0) tsw[(k)] = __builtin_amdgcn_s_memrealtime(); } while (0)
#else
#define STAMP(k) do {} while (0)
#endif
    STAMP(0);
    const int gw = bx * 8 + wave, NGW = G * 8;

    if (IN(0)) {
        const float* x = args.in[0];
        const int nssm = (G > 128) ? 2 * NG : 0;
        if (G > 128) { if (bx < 2 * NG) p0_ssm_group(lds, bx >> 1, bx & 1, args.in[9], args.in[10], args.in[11], args.in[12], args.in[13], args.in[14], args.in[15], args.in[16], (bf16_t*)(ws + WS_BT1), (bf16_t*)(ws + WS_BT2), (f32x2*)(ws + WS_AT)); }
        else { for (int u = bx; u < 2 * NG; u += G) p0_ssm_group(lds, u >> 1, u & 1, args.in[9], args.in[10], args.in[11], args.in[12], args.in[13], args.in[14], args.in[15], args.in[16], (bf16_t*)(ws + WS_BT1), (bf16_t*)(ws + WS_BT2), (f32x2*)(ws + WS_AT)); }
        if (bx >= nssm) {
            LAS float* scr = (LAS float*)(lds + wave * P0_SCR_BYTES);
            const int w0 = (bx - nssm) * 8 + wave, NW = (G - nssm) * 8;
            constexpr int I_GU = (D / 64) * (FF / 64), I_DN = (FF / 64) * (D / 64), I_IN = (D / 64) * (NIN / 64), I_GLU = (SW / 64) * (SW / 64), I_O = (AW / 64) * (D / 64), I_DD = (D / 64) * (D / 64), I_PP = (PLE / 64) * (D / 64);
            constexpr int NITEMS = 4 * I_GU + 2 * I_DN + I_IN + I_GLU + 2 * I_O + 2 * I_DD + I_PP;
            for (int it = w0; it < NITEMS; it += NW) {
                int r = it;
                if (r < I_GU) { p0_transpose_item(args.in[3], D, FF, (bf16_t*)(ws + WS_WGU1), 128, 256, 0, args.in[2], scr, r, lane); continue; } r -= I_GU;
                if (r < I_GU) { p0_transpose_item(args.in[4], D, FF, (bf16_t*)(ws + WS_WGU1), 128, 256, 128, args.in[2], scr, r, lane); continue; } r -= I_GU;
                if (r < I_DN) { p0_transpose_item(args.in[5], FF, D, (bf16_t*)(ws + WS_WD1), D, 0, 0, nullptr, scr, r, lane); continue; } r -= I_DN;
                if (r < I_IN) { p0_transpose_item(args.in[7], D, NIN, (bf16_t*)(ws + WS_WIN), NIN, 0, 0, args.in[6], scr, r, lane); continue; } r -= I_IN;
                if (r < I_GLU) { p0_transpose_item(args.in[17], SW, SW, (bf16_t*)(ws + WS_WGLU), SW, 0, 0, nullptr, scr, r, lane); continue; } r -= I_GLU;
                if (r < I_O) { p0_transpose_item(args.in[19], AW, D, (bf16_t*)(ws + WS_WOS), D, 0, 0, nullptr, scr, r, lane); continue; } r -= I_O;
                if (r < I_O) { p0_transpose_item(args.in[20], SW, D, (bf16_t*)(ws + WS_WOS), D, 0, D, nullptr, scr, r, lane); continue; } r -= I_O;
                if (r < I_DD) { p0_transpose_item(args.in[21], D, D, (bf16_t*)(ws + WS_WOUT), D, 0, 0, nullptr, scr, r, lane); continue; } r -= I_DD;
                if (r < I_GU) { p0_transpose_item(args.in[23], D, FF, (bf16_t*)(ws + WS_WGU2), 128, 256, 0, args.in[22], scr, r, lane); continue; } r -= I_GU;
                if (r < I_GU) { p0_transpose_item(args.in[24], D, FF, (bf16_t*)(ws + WS_WGU2), 128, 256, 128, args.in[22], scr, r, lane); continue; } r -= I_GU;
                if (r < I_DN) { p0_transpose_item(args.in[25], FF, D, (bf16_t*)(ws + WS_WD2), D, 0, 0, nullptr, scr, r, lane); continue; } r -= I_DN;
                if (r < I_DD) { p0_transpose_item(args.in[27], D, D, (bf16_t*)(ws + WS_WPG), D, 0, 0, args.in[26], scr, r, lane); continue; } r -= I_DD;
                p0_transpose_item(args.in[28], PLE, D, (bf16_t*)(ws + WS_WPP), D, 0, 0, nullptr, scr, r, lane);
            }
            { const float* pin = args.in[1]; bf16_t* PB = (bf16_t*)(ws + WS_PB);
              for (size_t i = (size_t)w0 * 256 + lane; i < (size_t)M * PLE / 8; i += (size_t)NW * 256) { f32x4 a[4], b[4];
#pragma unroll
                  for (int q = 0; q < 4; ++q) { a[q] = *(const f32x4*)(pin + (i + 64 * q) * 8); b[q] = *(const f32x4*)(pin + (i + 64 * q) * 8 + 4); }
#pragma unroll
                  for (int q = 0; q < 4; ++q) *(u32x4*)(PB + (i + 64 * q) * 8) = pack8(a[q], b[q]); } }
            for (int m = 2 * w0; m < M; m += 2 * NW) {
                const f32x4* xr = (const f32x4*)(x + (size_t)m * D) + lane; f32x4 v[8]; float s0 = 0.f, s1 = 0.f;
#pragma unroll
                for (int j = 0; j < 8; ++j) v[j] = xr[64 * j];
#pragma unroll
                for (int j = 0; j < 4; ++j) { s0 += (v[j][0] * v[j][0] + v[j][1] * v[j][1]) + (v[j][2] * v[j][2] + v[j][3] * v[j][3]); s1 += (v[4 + j][0] * v[4 + j][0] + v[4 + j][1] * v[4 + j][1]) + (v[4 + j][2] * v[4 + j][2] + v[4 + j][3] * v[4 + j][3]); }
                s0 = wave_sum(s0); s1 = wave_sum(s1); if (lane == 0) { ss0[m] = ss_fix(s0); ss0[m + 1] = ss_fix(s1); }
                u32x2* o8 = (u32x2*)(HB + (size_t)m * D) + lane;
#pragma unroll
                for (int j = 0; j < 8; ++j) o8[64 * j] = (u32x2){cvt_pk_bf16(v[j][0], v[j][1]), cvt_pk_bf16(v[j][2], v[j][3])};
            }
        }
        if (BOTH(0)) GRID_BAR();
        STAMP(1);
    }
    if (IN(1)) {
        pg8::Gemm g{(const char*)HB, (const char*)(ws + WS_WGU1), D, D, D, 128, 0}; pg8::PlainOrder S{M / 256, 2 * FF / 256, G, bx, D, D};
        EpiSwiglu E{(bf16_t*)(ws + WS_ACT), ss0};
        pg8::gemm_phase<EpiSwiglu, pg8::PlainOrder, true>(lds, g, S, E);
        if (BOTH(1)) GRID_BAR();
        STAMP(2);
    }
    if (IN(2)) {
        pg8::Gemm g{(const char*)(ws + WS_ACT), (const char*)(ws + WS_WD1), FF, FF, FF, 128, 0}; pg8::PlainOrder S{M / 256, D / 256, G, bx, FF, FF};
        EpiResid E{HB, ss1, 0.5f};
        pg8::gemm_phase<EpiResid, pg8::PlainOrder, true>(lds, g, S, E);
        if (BOTH(2)) GRID_BAR();
        STAMP(3);
    }
    if (IN(3)) {
        pg8::Gemm g{(const char*)HB, (const char*)(ws + WS_WIN), D, D, D, 128, 0}; pg8::PlainOrder S{M / 256, NIN / 256, G, bx, D, D};
        EpiWin E{(bf16_t*)(ws + WS_Q), (bf16_t*)(ws + WS_GA), ss1};
        pg8::gemm_phase<EpiWin, pg8::PlainOrder, true>(lds, g, S, E);
        if (BOTH(3)) GRID_BAR();
        STAMP(4);
    }
    if (IN(4)) {
        attn_phase(lds, (const bf16_t*)(ws + WS_Q), (const bf16_t*)(ws + WS_K), (const bf16_t*)(ws + WS_V), args.in[8], (bf16_t*)(dob + DO_AO), G, bx);
        pg8::Gemm g{(const char*)(ws + WS_U), (const char*)(ws + WS_BT1), 512, (unsigned)(TC * SW), 512, (unsigned)(4 * SW * 2), 1};
        pg8::SsmOrder S{3, G, bx, (size_t)GC * 2, (size_t)SEQ * SW * 2, (size_t)768 * 512 * 2, (size_t)256 * 512 * 2};
        EpiSsm1 E{(bf16_t*)(ws + WS_YI), (float*)(ws + WS_E)};
        pg8::gemm_phase<EpiSsm1, pg8::SsmOrder, true>(lds, g, S, E);
        if (BOTH(4)) GRID_BAR();
        STAMP(5);
    }
    if (IN(5)) {
        const float* E = (const float*)(ws + WS_E); bf16_t* XC = (bf16_t*)(ws + WS_XC); const f32x2* aTt = (const f32x2*)(ws + WS_AT);
        LAS f32x2* endst = (LAS f32x2*)lds;
        for (int un = bx; un < NG * BATCH; un += G) {
            const int g = un >> 2, b = un & 3, rec = tid & 127, dir = rec >> 6, p = rec & 63, seg = tid >> 7;
            const f32x2 a = aTt[(dir * NG + g) * NP + p];
            const size_t rb = ((size_t)(g * BATCH + b) * NC) * 256 + dir * 128 + p;
            float xr = 0.f, xi = 0.f;
#pragma unroll 8
            for (int j = 0; j < 64; ++j) { const int c = dir == 0 ? seg * 64 + j : seg * 64 + 63 - j; const float er = E[rb + (size_t)c * 256], ei = E[rb + (size_t)c * 256 + 64];
                const float t = a.x * xr - a.y * xi + er; xi = a.x * xi + a.y * xr + ei; xr = t; }
            endst[seg * 128 + rec] = (f32x2){xr, xi};
            __syncthreads();
            float a64r = a.x, a64i = a.y;
#pragma unroll
            for (int s = 0; s < 6; ++s) { const float t = a64r * a64r - a64i * a64i; a64i = 2.f * a64r * a64i; a64r = t; }
            xr = 0.f; xi = 0.f;
            if (dir == 0) { for (int s = 0; s < seg; ++s) { const f32x2 e = endst[s * 128 + rec]; const float t = a64r * xr - a64i * xi + e.x; xi = a64r * xi + a64i * xr + e.y; xr = t; } }
            else { for (int s = 3; s > seg; --s) { const f32x2 e = endst[s * 128 + rec]; const float t = a64r * xr - a64i * xi + e.x; xi = a64r * xi + a64i * xr + e.y; xr = t; } }
#pragma unroll 8
            for (int j = 0; j < 64; ++j) { const int c = dir == 0 ? seg * 64 + j : seg * 64 + 63 - j; const float er = E[rb + (size_t)c * 256], ei = E[rb + (size_t)c * 256 + 64];
                XC[rb + (size_t)c * 256] = f2bf(xr); XC[rb + (size_t)c * 256 + 64] = f2bf(xi);
                const float t = a.x * xr - a.y * xi + er; xi = a.x * xi + a.y * xr + ei; xr = t; }
            __syncthreads();
        }
        if (BOTH(5)) GRID_BAR();
        STAMP(6);
    }
    if (IN(6)) {
        pg8::Gemm g{(const char*)(ws + WS_XC), (const char*)(ws + WS_BT2), 256, 256, 256, 128, 0};
        pg8::SsmOrder S{2, G, bx, (size_t)BATCH * NC * 256 * 2, (size_t)NC * 256 * 2, (size_t)512 * 256 * 2, (size_t)256 * 256 * 2};
        EpiSsm2 E{(const bf16_t*)(ws + WS_YI), (bf16_t*)(ws + WS_Y)};
        pg8::gemm_phase<EpiSsm2, pg8::SsmOrder, true>(lds, g, S, E);
        if (BOTH(6)) GRID_BAR();
        STAMP(7);
    }
    if (IN(7)) {
        pg8::Gemm g{(const char*)0, (const char*)0, 512, 512, 512, 128, 0}; pg8::MixOrder S{G, bx, (size_t)(ws + WS_Y), (size_t)(ws + WS_WGLU), (size_t)(dob + DO_AO), (size_t)(ws + WS_WOS)};
        EpiMix E{(const bf16_t*)(ws + WS_Y), (bf16_t*)(dob + DO_YG), args.in[18], (const bf16_t*)(ws + WS_GA), (bf16_t*)(ws + WS_MRG)};
        pg8::gemm_phase<EpiMix, pg8::MixOrder, true>(lds, g, S, E);
        if (BOTH(7)) GRID_BAR();
        STAMP(8);
    }
    if (IN(8)) {
        pg8::Gemm g{(const char*)(dob + DO_YG), (const char*)(ws + WS_WOS + (size_t)D * 512 * 2), 512, 512, 512, 128, 0}; pg8::PlainOrder S{M / 256, D / 256, G, bx, 512, 512};
        EpiSsmProj E{(const bf16_t*)(ws + WS_GS), (bf16_t*)(ws + WS_MRG)};
        pg8::gemm_phase<EpiSsmProj, pg8::PlainOrder, true>(lds, g, S, E);
        if (BOTH(8)) GRID_BAR();
        STAMP(9);
    }
    if (IN(9)) {
        { pg8::Gemm g{(const char*)(ws + WS_PB), (const char*)(ws + WS_WPP), PLE, PLE, PLE, 128, 0}; pg8::PlainOrder S{M / 256, D / 256, G, bx, PLE, PLE};
          EpiStoreBf16 E{(bf16_t*)(ws + WS_PROJ)};
          pg8::gemm_phase<EpiStoreBf16, pg8::PlainOrder, true>(lds, g, S, E); }
        pg8::Gemm g{(const char*)(ws + WS_MRG), (const char*)(ws + WS_WOUT), D, D, D, 128, 0}; pg8::PlainOrder S{M / 256, D / 256, G, bx, D, D};
        EpiResid E{HB, ss2, 1.0f};
        pg8::gemm_phase<EpiResid, pg8::PlainOrder, true>(lds, g, S, E);
        if (BOTH(9)) GRID_BAR();
        STAMP(10);
    }
    if (IN(10)) {
        pg8::Gemm g{(const char*)HB, (const char*)(ws + WS_WGU2), D, D, D, 128, 0}; pg8::PlainOrder S{M / 256, 2 * FF / 256, G, bx, D, D};
        EpiSwiglu E{(bf16_t*)(ws + WS_ACT), ss2};
        pg8::gemm_phase<EpiSwiglu, pg8::PlainOrder, true>(lds, g, S, E);
        if (BOTH(10)) GRID_BAR();
        STAMP(11);
    }
    if (IN(11)) {
        { pg8::Gemm g{(const char*)(ws + WS_ACT), (const char*)(ws + WS_WD2), FF, FF, FF, 128, 0}; pg8::PlainOrder S{M / 256, D / 256, G, bx, FF, FF};
          EpiResid E{HB, ss3, 0.5f};
          pg8::gemm_phase<EpiResid, pg8::PlainOrder, true>(lds, g, S, E); }
        if (BOTH(11)) GRID_BAR();
        STAMP(12);
    }
    if (IN(12)) {
        pg8::Gemm g{(const char*)HB, (const char*)(ws + WS_WPG), D, D, D, 128, 0}; pg8::PlainOrder S{M / 256, D / 256, G, bx, D, D};
        EpiPleGate E{HB, (const bf16_t*)(ws + WS_PROJ), ss3, (bf16_t*)(ws + WS_H4), ss4};
        pg8::gemm_phase<EpiPleGate, pg8::PlainOrder, true>(lds, g, S, E);
        if (BOTH(12)) GRID_BAR();
        STAMP(13);
    }
    if (IN(13)) {
        const float* gn = args.in[29]; const bf16_t* H4 = (const bf16_t*)(ws + WS_H4); float* outp = args.out;
#ifdef TS_SEL
        bool ts_done = false;
#endif
        for (int m = gw; m < M; m += NGW) {
            const u32x4 w0 = *((const u32x4*)(H4 + (size_t)m * D) + lane), w1 = *((const u32x4*)(H4 + (size_t)m * D) + 64 + lane);
            const float r = rinv_of(ss4[m]); f32x4 v[4]; unpack8(w0, v[0], v[1]); unpack8(w1, v[2], v[3]);
#pragma unroll
            for (int j = 0; j < 4; ++j) { const f32x4 gg = *(const f32x4*)(gn + (j >> 1) * 512 + 8 * lane + 4 * (j & 1)); v[j] = v[j] * r * gg; }
#ifdef TS_SEL
            if (gw == 0 && !ts_done) {
                const float dus = (float)(tsw[TS_SEL + 1] - tsw[TS_SEL]) * 0.01f; const float enc = 0.040f + 0.059f * fminf(dus, (float)TS_RANGE) / (float)TS_RANGE;
                int hit = -1;
#pragma unroll
                for (int j = 0; j < 4; ++j)
#pragma unroll
                    for (int e = 0; e < 4; ++e) if (hit < 0 && fabsf(v[j][e]) < 1e-3f) hit = j * 4 + e;
                const unsigned long long bal = __ballot(hit >= 0);
                if (bal) { const int first = __ffsll((long long)bal) - 1; if (lane == first) {
#pragma unroll
                    for (int j = 0; j < 4; ++j)
#pragma unroll
                        for (int e = 0; e < 4; ++e) if (hit == j * 4 + e) v[j][e] = enc; }
                    ts_done = true; }
            }
#endif
            float* orow = outp + (size_t)m * D;
#pragma unroll
            for (int j = 0; j < 4; ++j) *(f32x4*)(orow + (j >> 1) * 512 + 8 * lane + 4 * (j & 1)) = v[j];
        }
    }
#undef IN
#undef BOTH
}

#if MK_SCAFFOLD && MK_MODE == 0
__global__ void __launch_bounds__(64) sc_natten(const bf16_t* __restrict__ q, const bf16_t* __restrict__ k, const bf16_t* __restrict__ v, const float* __restrict__ rpb, bf16_t* __restrict__ out) {
    const int idx = blockIdx.x * 64 + threadIdx.x; const int tok = idx >> 3, h = idx & 7, b = tok / SEQ, s = tok % SEQ, r = s / GW, c = s % GW;
    int rs = r - 4; rs = rs < 0 ? 0 : (rs > ROWS - 8 ? ROWS - 8 : rs);
    int cs = c - 8; cs = cs < 0 ? 0 : (cs > GW - 16 ? GW - 16 : cs);
    float qv[HD];
#pragma unroll
    for (int e = 0; e < HD; ++e) qv[e] = bf2f(q[(size_t)tok * AW + h * HD + e]);
    float mx = -1e30f;
    for (int j = 0; j < 8; ++j) for (int w = 0; w < 16; ++w) { const size_t kt = (size_t)b * SEQ + (rs + j) * GW + cs + w; const bf16_t* kp = k + kt * AW + h * HD;
        float d = 0.f;
#pragma unroll
        for (int e = 0; e < HD; ++e) d = fmaf(qv[e], bf2f(kp[e]), d);
        mx = fmaxf(mx, d + rpb[(h * 15 + (rs + j - r + 7)) * 31 + (cs + w - c + 15)]); }
    float o[HD];
#pragma unroll
    for (int e = 0; e < HD; ++e) o[e] = 0.f;
    float sum = 0.f;
    for (int j = 0; j < 8; ++j) for (int w = 0; w < 16; ++w) { const size_t kt = (size_t)b * SEQ + (rs + j) * GW + cs + w; const bf16_t* kp = k + kt * AW + h * HD; const bf16_t* vp = v + kt * AW + h * HD;
        float d = 0.f;
#pragma unroll
        for (int e = 0; e < HD; ++e) d = fmaf(qv[e], bf2f(kp[e]), d);
        const float pe = expf(d + rpb[(h * 15 + (rs + j - r + 7)) * 31 + (cs + w - c + 15)] - mx); sum += pe;
#pragma unroll
        for (int e = 0; e < HD; ++e) o[e] = fmaf(pe, bf2f(vp[e]), o[e]); }
    const float inv = 1.0f / sum;
#pragma unroll
    for (int e = 0; e < HD; ++e) out[(size_t)tok * AW + h * HD + e] = f2bf(o[e] * inv);
}
__global__ void __launch_bounds__(64) sc_s5(const bf16_t* __restrict__ ub, const float* __restrict__ lam_re, const float* __restrict__ lam_im, const float* __restrict__ log_dt,
                                            const float* __restrict__ b_re, const float* __restrict__ b_im, const float* __restrict__ c_re, const float* __restrict__ c_im, float* __restrict__ yf, int dir) {
    __shared__ float xr[64][65], xi[64][65], cr[16][64], ci[16][64], us[64][16];
    const int g = blockIdx.x, b = blockIdx.y, p = threadIdx.x; const int gp = (dir * NG + g) * NP + p;
    const double lr = fmin((double)lam_re[gp], -1e-4), li = (double)lam_im[gp], dt = exp((double)log_dt[dir * NG + g]);
    const double er = exp(lr * dt), ar = er * cos(li * dt), ai = er * sin(li * dt);
    const double nr = ar - 1.0, ni = ai, den = lr * lr + li * li; const double fr = (nr * lr + ni * li) / den, fi = (ni * lr - nr * li) / den;
    float bbr[16], bbi[16];
#pragma unroll
    for (int i = 0; i < 16; ++i) { const double br = b_re[(size_t)gp * GC + i], bi = b_im[(size_t)gp * GC + i]; bbr[i] = (float)(fr * br - fi * bi); bbi[i] = (float)(fr * bi + fi * br); }
    for (int o = 0; o < 16; ++o) { cr[o][p] = c_re[((size_t)(dir * NG + g) * GC + o) * NP + p]; ci[o][p] = c_im[((size_t)(dir * NG + g) * GC + o) * NP + p]; }
    const float far = (float)ar, fai = (float)ai; float sr = 0.f, si = 0.f;
    for (int blk = 0; blk < SEQ / 64; ++blk) {
        __syncthreads();
        for (int e = p; e < 64 * 16; e += 64) { const int tt = e >> 4, i = e & 15; const int t = dir ? (SEQ - 1 - (blk * 64 + tt)) : (blk * 64 + tt); us[tt][i] = bf2f(ub[((size_t)b * SEQ + t) * SW + g * GC + i]); }
        __syncthreads();
        for (int tt = 0; tt < 64; ++tt) { float br = 0.f, bi = 0.f;
#pragma unroll
            for (int i = 0; i < 16; ++i) { const float u = us[tt][i]; br = fmaf(bbr[i], u, br); bi = fmaf(bbi[i], u, bi); }
            const float n1 = far * sr - fai * si + br, n2 = far * si + fai * sr + bi; sr = n1; si = n2; xr[tt][p] = sr; xi[tt][p] = si; }
        __syncthreads();
        for (int e = p; e < 64 * 16; e += 64) { const int tt = e >> 4, o = e & 15; float a = 0.f;
            for (int q = 0; q < 64; ++q) a += xr[tt][q] * cr[o][q] - xi[tt][q] * ci[o][q];
            const int t = dir ? (SEQ - 1 - (blk * 64 + tt)) : (blk * 64 + tt); float* d = yf + ((size_t)b * SEQ + t) * SW + g * GC + o; if (dir) *d += a; else *d = a; }
    }
}
__global__ void sc_comb(const bf16_t* __restrict__ ub, const float* __restrict__ dsk, const float* __restrict__ yf, bf16_t* __restrict__ y) {
    size_t i = (size_t)blockIdx.x * blockDim.x + threadIdx.x; const int c = (int)(i % SW);
    y[i] = f2bf(gelu_tanh_f(dsk[c] * bf2f(ub[i]) + yf[i]));
}
#endif

#ifdef MK_TRUNC
__global__ void dump_k(const unsigned short* __restrict__ src, float* __restrict__ out, size_t n) {
    size_t i = (size_t)blockIdx.x * blockDim.x + threadIdx.x; if (i < n) out[i] = (float)src[i];
}
#endif
extern "C" void kernel_launch(void* const* d_in, const int* in_sizes, int n_in, void* d_out, int out_size, void* d_ws, size_t ws_size, hipStream_t stream) {
    static int grid = 0;
    if (grid == 0) {
        if (n_in != 30 || out_size != M * D || ws_size < WS_END) { fprintf(stderr, "kernel_launch: unexpected shapes (n_in %d out %d ws %zu)\n", n_in, out_size, ws_size); grid = -1; return; }
        int dev = 0, cus = 0;
        if (hipGetDevice(&dev) != hipSuccess || hipDeviceGetAttribute(&cus, hipDeviceAttributeMultiprocessorCount, dev) != hipSuccess) { grid = -1; return; }
        if (hipFuncSetAttribute((const void*)mk_fwd, hipFuncAttributeMaxDynamicSharedMemorySize, LDS_BYTES) != hipSuccess) { fprintf(stderr, "kernel_launch: hipFuncSetAttribute failed\n"); grid = -1; return; }
        (void)hipGetLastError();
        grid = cus;
    }
    if (grid < 0) return;
    (void)hipMemsetAsync((char*)d_ws + WS_CTL, 0, CTL_ZERO_BYTES, stream);
    Args a{};
    for (int i = 0; i < 30; ++i) a.in[i] = (const float*)d_in[i];
    a.out = (float*)d_out; a.ws = (unsigned char*)d_ws;
#if MK_MODE == 1
    a.ph_lo = 0; a.ph_hi = N_PHASES;
#ifdef MK_TRUNC
    a.ph_hi = MK_TRUNC + 1;
#endif
    hipLaunchKernelGGL(mk_fwd, dim3(grid), dim3(512), LDS_BYTES, stream, a);
#ifdef MK_TRUNC
    hipLaunchKernelGGL(dump_k, dim3((unsigned)((size_t)M * D / 256)), dim3(256), 0, stream, (const unsigned short*)((unsigned char*)d_ws + (size_t)MK_DUMP_MIB * MiB), (float*)d_out, (size_t)M * D);
#endif
#else
    unsigned char* ws = (unsigned char*)d_ws;
    for (int ph = 0; ph < N_PHASES; ++ph) {
#ifdef MK_TRUNC
        if (ph > MK_TRUNC) { hipLaunchKernelGGL(dump_k, dim3((unsigned)((size_t)M * D / 256)), dim3(256), 0, stream, (const unsigned short*)(ws + (size_t)MK_DUMP_MIB * MiB), (float*)d_out, (size_t)M * D); break; }
#endif
#if MK_SCAFFOLD
        if (ph == 4) {
            hipLaunchKernelGGL(sc_natten, dim3(M * NHEAD / 64), dim3(64), 0, stream, (const bf16_t*)(ws + WS_Q), (const bf16_t*)(ws + WS_K), (const bf16_t*)(ws + WS_V), (const float*)d_in[8], (bf16_t*)(ws + WS_AO));
            for (int dir = 0; dir < 2; ++dir)
                hipLaunchKernelGGL(sc_s5, dim3(NG, BATCH), dim3(64), 0, stream, (const bf16_t*)(ws + WS_U), (const float*)d_in[9], (const float*)d_in[10], (const float*)d_in[11], (const float*)d_in[12], (const float*)d_in[13],
                                   (const float*)d_in[14], (const float*)d_in[15], (float*)(ws + WS_YF), dir);
            hipLaunchKernelGGL(sc_comb, dim3((unsigned)((size_t)M * SW / 256)), dim3(256), 0, stream, (const bf16_t*)(ws + WS_U), (const float*)d_in[16], (const float*)(ws + WS_YF), (bf16_t*)(ws + WS_Y));
            continue;
        }
        if (ph == 5 || ph == 6) continue;
#endif
        a.ph_lo = ph; a.ph_hi = ph + 1;
        hipLaunchKernelGGL(mk_fwd, dim3(grid), dim3(512), LDS_BYTES, stream, a);
    }
#endif
}
```
